# Optimizing an MI355X kernel written in HIP

```python
import jax, jax.numpy as jnp
from jax import lax
import numpy as np

D_MODEL = 1024
BATCH = 8
SEQ = 4096
DEPTH = 2

D_MIX = D_MODEL
D_PLE = 256
D_FF = 4 * D_MODEL
EPS = 1e-6

ML_HEADS = 4
ML_DIM = D_MIX // 4
ML_HD = ML_DIM // ML_HEADS
ML_CHUNK = 64
ML_IN = 4 * ML_DIM + 2 * ML_HEADS

LRU_DIM = D_MIX // 4
LRU_BLOCKS = 4
LRU_BD = LRU_DIM // LRU_BLOCKS
CONV_W = 4
LRU_C = 8.0
LRU_IN = 2 * LRU_DIM

RW_DIM = D_MIX - ML_DIM - LRU_DIM
RW_HD = 64
RW_HEADS = RW_DIM // RW_HD
RW_W_LORA = 32
RW_A_LORA = 32
RW_G_LORA = 96
RW_IN = 3 * RW_DIM + RW_W_LORA + RW_A_LORA + RW_G_LORA
RW_GN_EPS = 64e-5

D_IN_PROJ = ML_IN + LRU_IN + RW_IN

kernel_name = "hybrid_mlstm_rglru_rwkv7_block"


def rms_norm(x, gain):
    x32 = x.astype(jnp.float32)
    y = x32 * lax.rsqrt(jnp.mean(x32 * x32, axis=-1, keepdims=True) + EPS) * gain
    return y.astype(x.dtype)


def token_shift(z):
    return jnp.pad(z, ((0, 0), (1, 0), (0, 0)))[:, :-1]


def mlstm_chunkwise(q, k, v, i_pre, f_pre):
    B, S, H, Dh = q.shape
    L = ML_CHUNK
    NC = S // L
    to_chunks = lambda t: t.reshape(B, NC, L, H, -1).transpose(0, 3, 1, 2, 4)
    qc = to_chunks(q) * (Dh ** -0.5)
    kc = to_chunks(k)
    vc = to_chunks(v)
    ig = to_chunks(i_pre[..., None])[..., 0]
    lf = to_chunks(jax.nn.log_sigmoid(f_pre)[..., None])[..., 0]
    F = jnp.cumsum(lf, axis=-1)
    F_tot = F[..., -1]

    lw = F_tot[..., None] - F + ig
    m_loc = jnp.max(lw, axis=-1)
    wgt = jnp.exp(lw - m_loc[..., None])
    C_loc = jnp.einsum('bhcl,bhclv,bhclk->bhcvk', wgt, vc, kc)
    n_loc = jnp.einsum('bhcl,bhclk->bhck', wgt, kc)

    def carry_state(state, inp):
        C, n, m = state
        C_l, n_l, m_l, f_tot = inp
        m_new = jnp.maximum(f_tot + m, m_l)
        a = jnp.exp(f_tot + m - m_new)
        b = jnp.exp(m_l - m_new)
        new = (a[..., None, None] * C + b[..., None, None] * C_l,
               a[..., None] * n + b[..., None] * n_l,
               m_new)
        return new, (C, n, m)

    cm = lambda t: jnp.moveaxis(t, 2, 0)
    init = (jnp.zeros((B, H, Dh, Dh), jnp.float32),
            jnp.zeros((B, H, Dh), jnp.float32),
            jnp.zeros((B, H), jnp.float32))
    _, (C_in, n_in, m_in) = lax.scan(carry_state, init,
                                     (cm(C_loc), cm(n_loc), cm(m_loc), cm(F_tot)))
    C_in = jnp.moveaxis(C_in, 0, 2)
    n_in = jnp.moveaxis(n_in, 0, 2)
    m_in = jnp.moveaxis(m_in, 0, 2)

    causal = jnp.tril(jnp.ones((L, L), dtype=bool))
    log_d = jnp.where(causal, F[..., :, None] - F[..., None, :] + ig[..., None, :], -jnp.inf)
    m_inter = F + m_in[..., None]
    m_row = jnp.maximum(m_inter, jnp.max(log_d, axis=-1))
    scores = jnp.einsum('bhcjd,bhcsd->bhcjs', qc, kc) * jnp.exp(log_d - m_row[..., None])
    w_inter = jnp.exp(m_inter - m_row)
    num = (jnp.einsum('bhcjs,bhcsv->bhcjv', scores, vc)
           + w_inter[..., None] * jnp.einsum('bhcvk,bhcjk->bhcjv', C_in, qc))
    den = jnp.sum(scores, axis=-1) + w_inter * jnp.einsum('bhck,bhcjk->bhcj', n_in, qc)
    h = num / jnp.maximum(jnp.abs(den), jnp.exp(-m_row))[..., None]
    return h.transpose(0, 2, 3, 1, 4).reshape(B, S, H, Dh)


def mlstm_group(z, gate_bias, head_norm):
    B, S, _ = z.shape
    z = z.astype(jnp.float32)
    q, k, v, o, i_pre, f_pre = jnp.split(
        z, [ML_DIM, 2 * ML_DIM, 3 * ML_DIM, 4 * ML_DIM, 4 * ML_DIM + ML_HEADS], axis=-1)
    hv = lambda t: t.reshape(B, S, ML_HEADS, ML_HD)
    h = mlstm_chunkwise(hv(q), hv(k), hv(v), i_pre + gate_bias[0], f_pre + gate_bias[1])
    h = rms_norm(h, head_norm.reshape(ML_HEADS, ML_HD)).reshape(B, S, ML_DIM)
    return h * jax.nn.sigmoid(o)


def rglru_group(z, conv_w, conv_b, w_r, b_r, w_i, b_i, lam):
    B, S, _ = z.shape
    z = z.astype(jnp.float32)
    xb, gb = jnp.split(z, [LRU_DIM], axis=-1)
    xc = lax.conv_general_dilated(
        xb, conv_w[:, None, :].astype(xb.dtype), window_strides=(1,),
        padding=[(CONV_W - 1, 0)], dimension_numbers=('NWC', 'WIO', 'NWC'),
        feature_group_count=LRU_DIM) + conv_b
    xblk = xc.reshape(B, S, LRU_BLOCKS, LRU_BD)
    r = jax.nn.sigmoid(jnp.einsum('bsnd,nde->bsne', xblk, w_r).reshape(B, S, LRU_DIM) + b_r)
    i = jax.nn.sigmoid(jnp.einsum('bsnd,nde->bsne', xblk, w_i).reshape(B, S, LRU_DIM) + b_i)
    log_a = -LRU_C * r * jax.nn.softplus(-lam)
    a = jnp.exp(log_a)
    u = jnp.sqrt(-jnp.expm1(2.0 * log_a)) * (i * xc)

    def combine(left, right):
        a1, b1 = left
        a2, b2 = right
        return a1 * a2, a2 * b1 + b2

    _, h = lax.associative_scan(combine, (a, u), axis=1)
    return h * jax.nn.gelu(gb)


def rwkv7_recurrence(r, decay, k, v, kk, a):
    B, S, H, Dh = r.shape

    def step(state, inp):
        r_t, w_t, k_t, v_t, kk_t, a_t = inp
        sa = jnp.einsum('bhvk,bhk->bhv', state, -kk_t)
        state = (state * w_t[:, :, None, :]
                 + sa[..., None] * (kk_t * a_t)[:, :, None, :]
                 + v_t[..., None] * k_t[:, :, None, :])
        return state, jnp.einsum('bhvk,bhk->bhv', state, r_t)

    init = jnp.zeros((B, H, Dh, Dh), jnp.float32)
    xs = tuple(jnp.moveaxis(t, 1, 0) for t in (r, decay, k, v, kk, a))
    _, out = lax.scan(step, init, xs)
    return jnp.moveaxis(out, 0, 1)


def rwkv7_group(z, mu, w0, w2, a0, a2, g2, k_k, k_a, r_k, ln_w, ln_b):
    B, S, _ = z.shape
    z = z.astype(jnp.float32)
    z = z + (token_shift(z) - z) * mu
    r, k, v, wd, ad, gd = jnp.split(
        z, [RW_DIM, 2 * RW_DIM, 3 * RW_DIM, 3 * RW_DIM + RW_W_LORA,
            3 * RW_DIM + RW_W_LORA + RW_A_LORA], axis=-1)
    w = -jax.nn.softplus(-(w0 + jnp.tanh(wd) @ w2)) - 0.5
    decay = jnp.exp(-jnp.exp(w))
    a = jax.nn.sigmoid(a0 + ad @ a2)
    g = jax.nn.sigmoid(gd) @ g2
    hv = lambda t: t.reshape(B, S, RW_HEADS, RW_HD)
    kk = hv(k * k_k)
    kk = kk / jnp.maximum(jnp.linalg.norm(kk, axis=-1, keepdims=True), 1e-12)
    k = k * (1.0 + (a - 1.0) * k_a)
    rh, kh, vh = hv(r), hv(k), hv(v)
    o = rwkv7_recurrence(rh, hv(decay), kh, vh, kk, hv(a))
    mean = jnp.mean(o, axis=-1, keepdims=True)
    var = jnp.mean(jnp.square(o - mean), axis=-1, keepdims=True)
    o = ((o - mean) * lax.rsqrt(var + RW_GN_EPS)).reshape(B, S, RW_DIM) * ln_w + ln_b
    bonus = jnp.sum(rh * kh * r_k, axis=-1, keepdims=True) * vh
    return (o + bonus.reshape(B, S, RW_DIM)) * g


def setup_inputs(seed: int = 0) -> dict:
    key = jax.random.key(seed)
    ks = iter(jax.random.split(key, 48))
    nrm = lambda shape, scale: jax.random.normal(next(ks), shape, jnp.float32) * scale
    gain = lambda shape: 1.0 + nrm(shape, 0.05)
    u = jax.random.uniform(next(ks), (DEPTH, LRU_DIM), jnp.float32, 0.9, 0.999)
    s = u ** (1.0 / LRU_C)
    lam = jnp.log(s) - jnp.log1p(-s)
    i_bias = -1.0 + nrm((DEPTH, 1, ML_HEADS), 0.1)
    f_bias = jax.random.uniform(next(ks), (DEPTH, 1, ML_HEADS), jnp.float32, 3.0, 6.0)
    return {
        "x": nrm((BATCH, SEQ, D_MODEL), 1.0),
        "p": nrm((DEPTH, BATCH, SEQ, D_PLE), 1.0),
        "norm_mix_pre": gain((DEPTH, D_MODEL)),
        "norm_mix_post": gain((DEPTH, D_MODEL)),
        "norm_ffn_pre": gain((DEPTH, D_MODEL)),
        "norm_ffn_post": gain((DEPTH, D_MODEL)),
        "norm_ple": gain((DEPTH, D_MODEL)),
        "w_in": nrm((DEPTH, D_MODEL, D_IN_PROJ), D_MODEL ** -0.5),
        "w_out": nrm((DEPTH, D_MIX, D_MODEL), D_MIX ** -0.5),
        "ml_gate_bias": jnp.concatenate([i_bias, f_bias], axis=1),
        "ml_head_norm": gain((DEPTH, ML_DIM)),
        "lru_conv_w": nrm((DEPTH, CONV_W, LRU_DIM), CONV_W ** -0.5),
        "lru_conv_b": nrm((DEPTH, LRU_DIM), 0.02),
        "lru_w_r": nrm((DEPTH, LRU_BLOCKS, LRU_BD, LRU_BD), LRU_BD ** -0.5),
        "lru_b_r": nrm((DEPTH, LRU_DIM), 0.1),
        "lru_w_i": nrm((DEPTH, LRU_BLOCKS, LRU_BD, LRU_BD), LRU_BD ** -0.5),
        "lru_b_i": nrm((DEPTH, LRU_DIM), 0.1),
        "lru_lambda": lam,
        "rw_mu": jax.random.uniform(next(ks), (DEPTH, RW_IN), jnp.float32),
        "rw_w0": jax.random.uniform(next(ks), (DEPTH, RW_DIM), jnp.float32, -2.0, 1.0),
        "rw_w2": nrm((DEPTH, RW_W_LORA, RW_DIM), 0.1 * RW_W_LORA ** -0.5),
        "rw_a0": nrm((DEPTH, RW_DIM), 0.1),
        "rw_a2": nrm((DEPTH, RW_A_LORA, RW_DIM), 0.1 * RW_A_LORA ** -0.5),
        "rw_g2": nrm((DEPTH, RW_G_LORA, RW_DIM), RW_G_LORA ** -0.5),
        "rw_k_k": 0.85 + nrm((DEPTH, RW_DIM), 0.05),
        "rw_k_a": 1.0 + nrm((DEPTH, RW_DIM), 0.05),
        "rw_r_k": nrm((DEPTH, RW_HEADS, RW_HD), 0.1),
        "rw_ln_w": gain((DEPTH, RW_DIM)),
        "rw_ln_b": nrm((DEPTH, RW_DIM), 0.02),
        "ffn_w1": nrm((DEPTH, D_MODEL, D_FF), D_MODEL ** -0.5),
        "ffn_w2": nrm((DEPTH, D_FF, D_MODEL), D_FF ** -0.5),
        "ple_w_proj": nrm((DEPTH, D_PLE, D_MODEL), D_PLE ** -0.5),
        "ple_w_gate": nrm((DEPTH, D_MODEL, D_MODEL), D_MODEL ** -0.5),
    }


def reference(x, p, norm_mix_pre, norm_mix_post, norm_ffn_pre, norm_ffn_post, norm_ple,
              w_in, w_out, ml_gate_bias, ml_head_norm,
              lru_conv_w, lru_conv_b, lru_w_r, lru_b_r, lru_w_i, lru_b_i, lru_lambda,
              rw_mu, rw_w0, rw_w2, rw_a0, rw_a2, rw_g2, rw_k_k, rw_k_a, rw_r_k, rw_ln_w, rw_ln_b,
              ffn_w1, ffn_w2, ple_w_proj, ple_w_gate):
    for l in range(DEPTH):
        h = rms_norm(x, norm_mix_pre[l])
        z = h @ w_in[l]
        z_ml = z[..., :ML_IN]
        z_lru = z[..., ML_IN:ML_IN + LRU_IN]
        z_rw = z[..., ML_IN + LRU_IN:]
        y_ml = mlstm_group(z_ml, ml_gate_bias[l], ml_head_norm[l])
        y_lru = rglru_group(z_lru, lru_conv_w[l], lru_conv_b[l], lru_w_r[l], lru_b_r[l],
                            lru_w_i[l], lru_b_i[l], lru_lambda[l])
        y_rw = rwkv7_group(z_rw, rw_mu[l], rw_w0[l], rw_w2[l], rw_a0[l], rw_a2[l], rw_g2[l],
                           rw_k_k[l], rw_k_a[l], rw_r_k[l], rw_ln_w[l], rw_ln_b[l])
        mix = jnp.concatenate([y_ml, y_lru, y_rw], axis=-1).astype(x.dtype) @ w_out[l]
        x = x + rms_norm(mix, norm_mix_post[l])
        h = rms_norm(x, norm_ffn_pre[l])
        f = jnp.square(jax.nn.relu(h @ ffn_w1[l])) @ ffn_w2[l]
        x = x + rms_norm(f, norm_ffn_post[l])
        e = jax.nn.sigmoid(x @ ple_w_gate[l]) * (p[l] @ ple_w_proj[l])
        x = x + rms_norm(e, norm_ple[l])
    return x
```

```cpp
#include <hip/hip_runtime.h>
#include <hip/hip_cooperative_groups.h>
#include <cstdio>
#include <cstdint>
namespace cg = cooperative_groups;

constexpr int BATCH = 8, SEQ = 4096, DM = 1024, DEPTH = 2, DPLE = 256, DFF = 4096;
constexpr int MTOK = BATCH * SEQ;
constexpr int NZ = 3328;
constexpr int ZC_Q = 0, ZC_K = 256, ZC_V = 512, ZC_O = 768, ZC_I = 1024, ZC_F = 1028, ZC_XB = 1032, ZC_GB = 1288;
constexpr int ZC_RW = 1544, ZC_RR = 1544, ZC_RK = 2056, ZC_RV = 2568, ZC_WD = 3080, ZC_AD = 3112, ZC_GD = 3144, DIN = 3240;
constexpr float EPS = 1e-6f;
namespace pg8 {
#define PG8_LAS __attribute__((address_space(3)))
typedef unsigned short bf16_t;
typedef short bf16x8 __attribute__((ext_vector_type(8)));
typedef float f32x4 __attribute__((ext_vector_type(4)));
typedef unsigned u32x4 __attribute__((ext_vector_type(4)));
constexpr int BM = 256, BK = 64, HALF = 128, HTB = HALF * BK * 2  , STAGE_BYTES = 8 * HTB, NXCD = 8, WGM = 8;

__host__ __device__ __forceinline__ int lds_byte(int r, int c) { const int st = (r >> 4) * 2 + (c >> 5), rr = r & 15, cc = c & 31, ob = rr * 64 + cc * 2; return st * 1024 + (ob ^ (((ob >> 9) & 1) << 5)); }
__host__ __device__ __forceinline__ void stage_rc(int b, int& R, int& C) { const int st = b / 1024, sb = b % 1024, swz = sb ^ (((sb >> 9) & 1) << 5); R = (st >> 1) * 16 + swz / 64; C = (st & 1) * 32 + (swz % 64) / 2; }
__host__ __device__ __forceinline__ int perm32(int rho) { const int n = rho >> 4, i = rho & 15; return 8 * (i >> 2) + 4 * n + (i & 3); }

struct Unit { int pm, pn; };
struct Gemm { const bf16_t* A; const bf16_t* Bt; int M, N, K; };

struct StaticOrder {
    int nM, nN, nwg, G, c;
    __host__ __device__ void init(int M, int N, int G_, int c_) { nM = M / BM; nN = N / BM; nwg = nM * nN; G = G_; c = c_; }
    __host__ __device__ bool next(int i, Unit& u) const {
        const long L = (long)i * G + c; if (L >= nwg) return false;
        int wgid = (int)L; { const int q = nwg / NXCD, r = nwg % NXCD, xcd = wgid % NXCD, off = wgid / NXCD; wgid = (xcd < r ? xcd * (q + 1) : r * (q + 1) + (xcd - r) * q) + off; }
        const int nig = WGM * nN, gid = wgid / nig, fm = gid * WGM, gsz = (nM - fm) < WGM ? (nM - fm) : WGM;
        u.pm = fm + ((wgid % nig) % gsz); u.pn = (wgid % nig) / gsz; return true;
    }
    __device__ __forceinline__ void a_ready(const Unit&) const {}
    __device__ __forceinline__ void done(const Unit&) const {}
};

__device__ __forceinline__ unsigned cvt_pk_bf16(float lo, float hi) { unsigned r; asm volatile("v_cvt_pk_bf16_f32 %0, %1, %2" : "=v"(r) : "v"(lo), "v"(hi)); return r; }
__device__ __forceinline__ float bfl(unsigned w) { return __uint_as_float(w << 16); }
__device__ __forceinline__ float bfh(unsigned w) { return __uint_as_float(w & 0xffff0000u); }
__device__ __forceinline__ float sigm(float x) { return 1.0f / (1.0f + __expf(-x)); }
template <int MODE> struct EpiOut {
    static constexpr bool PERM = true, AFTER_DRAIN = false;
    bf16_t* O; int ldc; float* ssq;
    __device__ __forceinline__ void operator()(const f32x4 (&acc)[2][2][4][2], const Unit& u, int wr, int wc, int fr, int fq) const {
        const int row0 = u.pm * BM + wr * 64 + fr, col0 = u.pn * BM + wc * 32 + 8 * fq;
#pragma unroll
        for (int ai = 0; ai < 2; ++ai)
#pragma unroll
            for (int m = 0; m < 4; ++m) { const int row = row0 + ai * HALF + m * 16; bf16_t* rowp = O + (size_t)row * ldc + col0; float ss = 0.f;
#pragma unroll
                for (int bj = 0; bj < 2; ++bj) { f32x4 v0 = acc[ai][bj][m][0], v1 = acc[ai][bj][m][1];
                    if (MODE == 1) {
#pragma unroll
                        for (int e = 0; e < 4; ++e) { const float a = fmaxf(v0[e], 0.f), b = fmaxf(v1[e], 0.f); v0[e] = a * a; v1[e] = b * b; } }
                    if (MODE == 3) { const u32x4 pp = *(const u32x4*)(rowp + bj * HALF);
                        v0[0] = sigm(v0[0]) * bfl(pp.x); v0[1] = sigm(v0[1]) * bfh(pp.x); v0[2] = sigm(v0[2]) * bfl(pp.y); v0[3] = sigm(v0[3]) * bfh(pp.y);
                        v1[0] = sigm(v1[0]) * bfl(pp.z); v1[1] = sigm(v1[1]) * bfh(pp.z); v1[2] = sigm(v1[2]) * bfl(pp.w); v1[3] = sigm(v1[3]) * bfh(pp.w); }
                    if (MODE >= 2) ss += (v0[0] * v0[0] + v0[1] * v0[1]) + (v0[2] * v0[2] + v0[3] * v0[3]) + (v1[0] * v1[0] + v1[1] * v1[1]) + (v1[2] * v1[2] + v1[3] * v1[3]);
                    u32x4 w; w.x = cvt_pk_bf16(v0[0], v0[1]); w.y = cvt_pk_bf16(v0[2], v0[3]); w.z = cvt_pk_bf16(v1[0], v1[1]); w.w = cvt_pk_bf16(v1[2], v1[3]);
                    *(u32x4*)(rowp + bj * HALF) = w; }
                if (MODE >= 2) { ss += __shfl_xor(ss, 16); ss += __shfl_xor(ss, 32); if (fq == 0) ssq[(size_t)row * 16 + u.pn * 4 + wc] = ss; } }
    }
};

template <class Epi, class Sched, bool ALIGN_EPI = false, bool SP2 = false>
__device__ __forceinline__ void gemm_phase(PG8_LAS unsigned char* lds, const Gemm g, const Sched& S, const Epi& E, const int tid) {
    const int wid = __builtin_amdgcn_readfirstlane(tid >> 6), lane = tid & 63, wr = wid >> 2, wc = wid & 3, fr = lane & 15, fq = lane >> 4;
    const int K = g.K, nt = K / BK;
    unsigned voffA[2], voffB[2];
#pragma unroll
    for (int i = 0; i < 2; ++i) { int R, C; stage_rc(tid * 16 + i * 8192, R, C); const int Rb = Epi::PERM ? ((R & ~31) + perm32(R & 31)) : R;
        voffA[i] = (unsigned)(R * K + C) * 2u; voffB[i] = (unsigned)(Rb * K + C) * 2u; }
    const size_t kstep = (size_t)(BK * 2);
    const size_t hstep = (size_t)HALF * K * 2;
    const size_t tstep = 2 * hstep;
    const unsigned ldsw = (unsigned)wid * 1024u;
    const int aoff = lds_byte(wr * 64 + fr, fq * 8), boff = lds_byte(wc * 32 + fr, fq * 8);
#define PG8_SA(b, h) (((b) * 2 + (h)) * HTB)
#define PG8_SB(b, h) ((4 + (b) * 2 + (h)) * HTB)
#define PG8_STAGE(bufoff, gbase, voff) do { _Pragma("unroll") for (int _i = 0; _i < 2; ++_i) \
        __builtin_amdgcn_global_load_lds((const unsigned*)((const char*)(gbase) + (voff)[_i]), (PG8_LAS unsigned*)(lds + (bufoff) + ldsw + _i * 8192), 16, 0, 0); } while (0)
#define PG8_LDA(dst, b, h) do { _Pragma("unroll") for (int m = 0; m < 4; ++m) _Pragma("unroll") for (int k = 0; k < 2; ++k) dst[m][k] = *(const PG8_LAS bf16x8*)(lds + PG8_SA(b, h) + aoff + m * 2048 + k * 1024); } while (0)
#define PG8_LDB(dst, b, h) do { _Pragma("unroll") for (int n = 0; n < 2; ++n) _Pragma("unroll") for (int k = 0; k < 2; ++k) dst[n][k] = *(const PG8_LAS bf16x8*)(lds + PG8_SB(b, h) + boff + n * 2048 + k * 1024); } while (0)
#define PG8_MMA(ai, bj, At, Bt) do { __builtin_amdgcn_s_setprio(1); _Pragma("unroll") for (int m = 0; m < 4; ++m) _Pragma("unroll") for (int n = 0; n < 2; ++n) _Pragma("unroll") for (int k = 0; k < 2; ++k) \
        acc[ai][bj][m][n] = __builtin_amdgcn_mfma_f32_16x16x32_bf16(Bt[n][k], At[m][k], acc[ai][bj][m][n], 0, 0, 0); __builtin_amdgcn_s_setprio(0); } while (0)
#define PG8_WAIT_V(n) asm volatile("s_waitcnt vmcnt(" #n ")" ::: "memory")
#define PG8_WAIT_L(n) asm volatile("s_waitcnt lgkmcnt(" #n ")" ::: "memory")
#define PG8_BAR __builtin_amdgcn_s_barrier()
#define PG8_SCHED __builtin_amdgcn_sched_barrier(0)
    Unit cur, nxt; int ui = 0;
    if (!S.next(0, cur)) return;
    f32x4 acc[2][2][4][2];
#pragma unroll
    for (int a = 0; a < 2; ++a)
#pragma unroll
        for (int b = 0; b < 2; ++b)
#pragma unroll
            for (int m = 0; m < 4; ++m)
#pragma unroll
                for (int n = 0; n < 2; ++n) acc[a][b][m][n] = (f32x4){0.f, 0.f, 0.f, 0.f};
    bf16x8 At[4][2], B0[2][2], B1[2][2];
    const char* cA = (const char*)g.A + (size_t)cur.pm * tstep; const char* cB = (const char*)g.Bt + (size_t)cur.pn * tstep;
    S.a_ready(cur);
    if constexpr (SP2) {
        PG8_STAGE(PG8_SB(0, 0), cB, voffB); PG8_STAGE(PG8_SB(0, 1), cB + hstep, voffB); PG8_STAGE(PG8_SA(0, 0), cA, voffA); PG8_STAGE(PG8_SA(0, 1), cA + hstep, voffA);
        if (wr == 1) PG8_BAR;
        PG8_WAIT_V(2); PG8_BAR;
        PG8_STAGE(PG8_SB(1, 0), cB + kstep, voffB); PG8_STAGE(PG8_SA(1, 0), cA + kstep, voffA); PG8_STAGE(PG8_SB(1, 1), cB + hstep + kstep, voffB);
        PG8_WAIT_V(6); PG8_BAR;
    } else {
        PG8_STAGE(PG8_SB(0, 0), cB, voffB); PG8_STAGE(PG8_SA(0, 0), cA, voffA); PG8_STAGE(PG8_SB(0, 1), cB + hstep, voffB); PG8_STAGE(PG8_SA(0, 1), cA + hstep, voffA);
        if (wr == 1) PG8_BAR;
        PG8_WAIT_V(4); PG8_BAR;
        PG8_STAGE(PG8_SB(1, 0), cB + kstep, voffB); PG8_STAGE(PG8_SA(1, 0), cA + kstep, voffA); PG8_STAGE(PG8_SB(1, 1), cB + hstep + kstep, voffB);
        PG8_WAIT_V(6); PG8_BAR;
    }
    for (;;) {
        const bool has_next = S.next(ui + 1, nxt);
        const char* nA = has_next ? (const char*)g.A + (size_t)nxt.pm * tstep : cA; const char* nB = has_next ? (const char*)g.Bt + (size_t)nxt.pn * tstep : cB;
        for (int t = 0; t < nt; t += 2) {
            const bool last = (t == nt - 2);
            const char* a1 = cA + (size_t)(t + 1) * kstep;
            const char* a2 = last ? nA : cA + (size_t)(t + 2) * kstep; const char* b2 = last ? nB : cB + (size_t)(t + 2) * kstep;
            const char* a3 = a2 + kstep; const char* b3 = b2 + kstep;
            if (last && has_next) S.a_ready(nxt);
            if constexpr (SP2) {
            PG8_LDB(B0, 0, 0); PG8_LDB(B1, 0, 1); PG8_SCHED; PG8_LDA(At, 0, 0); PG8_STAGE(PG8_SA(1, 1), a1 + hstep, voffA);
            PG8_WAIT_V(8); PG8_WAIT_L(0); PG8_BAR; PG8_MMA(0, 0, At, B0); PG8_MMA(0, 1, At, B1); PG8_BAR; PG8_SCHED;
            PG8_LDA(At, 0, 1); PG8_STAGE(PG8_SB(0, 0), b2, voffB); PG8_STAGE(PG8_SB(0, 1), b2 + hstep, voffB); PG8_STAGE(PG8_SA(0, 0), a2, voffA);
            PG8_WAIT_V(8); PG8_WAIT_L(0); PG8_BAR; PG8_MMA(1, 0, At, B0); PG8_MMA(1, 1, At, B1); PG8_BAR; PG8_SCHED;
            PG8_LDB(B0, 1, 0); PG8_LDB(B1, 1, 1); PG8_SCHED; PG8_LDA(At, 1, 0); PG8_STAGE(PG8_SA(0, 1), a2 + hstep, voffA);
            PG8_WAIT_V(8); PG8_WAIT_L(0); PG8_BAR; PG8_MMA(0, 0, At, B0); PG8_MMA(0, 1, At, B1); PG8_BAR; PG8_SCHED;
            PG8_LDA(At, 1, 1); PG8_STAGE(PG8_SB(1, 0), b3, voffB); PG8_STAGE(PG8_SB(1, 1), b3 + hstep, voffB); PG8_STAGE(PG8_SA(1, 0), a3, voffA);
            PG8_WAIT_V(8); PG8_WAIT_L(0); PG8_BAR; PG8_MMA(1, 0, At, B0); PG8_MMA(1, 1, At, B1); PG8_BAR; PG8_SCHED;
            } else {
            PG8_LDB(B0, 0, 0); PG8_SCHED; PG8_LDA(At, 0, 0); PG8_STAGE(PG8_SA(1, 1), a1 + hstep, voffA);
            PG8_WAIT_L(8); PG8_BAR; PG8_WAIT_L(0); PG8_MMA(0, 0, At, B0); PG8_BAR; PG8_SCHED;
            PG8_LDB(B1, 0, 1); PG8_STAGE(PG8_SB(0, 0), b2, voffB);
            PG8_BAR; PG8_WAIT_L(0); PG8_MMA(0, 1, At, B1); PG8_BAR;
            PG8_LDA(At, 0, 1); PG8_STAGE(PG8_SA(0, 0), a2, voffA);
            PG8_BAR; PG8_WAIT_L(0); PG8_MMA(1, 0, At, B0); PG8_BAR; PG8_SCHED;
            PG8_STAGE(PG8_SB(0, 1), b2 + hstep, voffB);
            PG8_WAIT_V(6); PG8_BAR; PG8_MMA(1, 1, At, B1); PG8_BAR;
            PG8_LDB(B0, 1, 0); PG8_SCHED; PG8_LDA(At, 1, 0); PG8_STAGE(PG8_SA(0, 1), a2 + hstep, voffA);
            PG8_WAIT_L(8); PG8_BAR; PG8_WAIT_L(0); PG8_MMA(0, 0, At, B0); PG8_BAR; PG8_SCHED;
            PG8_LDB(B1, 1, 1); PG8_STAGE(PG8_SB(1, 0), b3, voffB);
            PG8_BAR; PG8_WAIT_L(0); PG8_MMA(0, 1, At, B1); PG8_BAR;
            PG8_LDA(At, 1, 1); PG8_STAGE(PG8_SA(1, 0), a3, voffA);
            PG8_BAR; PG8_WAIT_L(0); PG8_MMA(1, 0, At, B0); PG8_BAR; PG8_SCHED;
            PG8_STAGE(PG8_SB(1, 1), b3 + hstep, voffB);
            PG8_WAIT_V(6); PG8_BAR; PG8_MMA(1, 1, At, B1); PG8_BAR;
            }
        }
        if constexpr (ALIGN_EPI) { if (wr == 0) PG8_BAR; }
        if constexpr (!Epi::AFTER_DRAIN) { E(acc, cur, wr, wc, fr, fq); S.done(cur); }
        if (!has_next) break;
#pragma unroll
        for (int a = 0; a < 2; ++a)
#pragma unroll
            for (int b = 0; b < 2; ++b)
#pragma unroll
                for (int m = 0; m < 4; ++m)
#pragma unroll
                    for (int n = 0; n < 2; ++n) acc[a][b][m][n] = (f32x4){0.f, 0.f, 0.f, 0.f};
        cur = nxt; cA = nA; cB = nB; ++ui;
        if constexpr (ALIGN_EPI) { if (wr == 1) PG8_BAR; }
    }
    PG8_WAIT_V(0);
    if constexpr (!ALIGN_EPI) { if (wr == 0) PG8_BAR; }
    PG8_BAR;
    if constexpr (Epi::AFTER_DRAIN) { E.fused(acc, cur, wr, wc, fr, fq, lds, wid, lane); S.done(cur); }
#undef PG8_SA
#undef PG8_SB
#undef PG8_STAGE
#undef PG8_LDA
#undef PG8_LDB
#undef PG8_MMA
#undef PG8_WAIT_V
#undef PG8_WAIT_L
#undef PG8_BAR
#undef PG8_SCHED
}
}
#define LAS __attribute__((address_space(3)))
typedef unsigned short bf16;
typedef short bf16x8 __attribute__((ext_vector_type(8)));
typedef float f32x4 __attribute__((ext_vector_type(4)));
typedef unsigned u32x4 __attribute__((ext_vector_type(4)));
typedef unsigned u32x2 __attribute__((ext_vector_type(2)));
typedef float f32x2 __attribute__((ext_vector_type(2)));
typedef __bf16 bf16x2_t __attribute__((ext_vector_type(2)));

constexpr size_t MiB = 1u << 20;
constexpr size_t WS_CTL = 0, WS_SSQ = 1 * MiB, WS_BON = 3 * MiB, WS_W = 4 * MiB, WS_PB = 58 * MiB, WS_XN = 90 * MiB, WS_Y = 154 * MiB, WS_ZH = 218 * MiB, WS_END = 474 * MiB;
constexpr size_t WO_IN = 0, WO_OUT = WO_IN + (size_t)NZ * DM, WO_1 = WO_OUT + (size_t)DM * DM, WO_2 = WO_1 + (size_t)DFF * DM, WO_G = WO_2 + (size_t)DM * DFF, WO_P = WO_G + (size_t)DM * DM, WO_LAYER = WO_P + (size_t)DM * DPLE;
static_assert(WS_W + 2 * WO_LAYER * 2 <= WS_PB, "weight region");
constexpr int LDS_BYTES = 147456;
constexpr int NWAVES = 8, NTHR = 512;

struct Args { const float* in[33]; float* out; unsigned char* ws; int ph_lo, ph_hi; };

__device__ __forceinline__ float bf2f(unsigned short h) { return __uint_as_float((unsigned)h << 16); }
__device__ __forceinline__ float bflo(unsigned w) { return __uint_as_float(w << 16); }
__device__ __forceinline__ float bfhi(unsigned w) { return __uint_as_float(w & 0xffff0000u); }
__device__ __forceinline__ unsigned pk2(float lo, float hi) { f32x2 v = {lo, hi}; bf16x2_t b = __builtin_convertvector(v, bf16x2_t); return __builtin_bit_cast(unsigned, b); }
__device__ __forceinline__ unsigned short f2bf(float f) { return (unsigned short)(pk2(f, 0.f) & 0xffffu); }
__device__ __forceinline__ float sigmoidf_(float x) { return 1.0f / (1.0f + __expf(-x)); }
__device__ __forceinline__ float softplusf_(float x) { return fmaxf(x, 0.f) + log1pf(__expf(-fabsf(x))); }
__device__ __forceinline__ float wave_sum(float v) {
#pragma unroll
    for (int o = 1; o < 64; o <<= 1) v += __shfl_xor(v, o);
    return v;
}
template <int CTRL> __device__ __forceinline__ float dppf(float x) { return __builtin_bit_cast(float, __builtin_amdgcn_update_dpp(0, __builtin_bit_cast(int, x), CTRL, 0xf, 0xf, true)); }
__device__ __forceinline__ float row16_sum(float x) {
    x += dppf<0x128>(x); x += dppf<0x124>(x); x += dppf<0x122>(x); x += dppf<0x121>(x); return x;
}
#define LDS_WAIT() asm volatile("s_waitcnt lgkmcnt(0)" ::: "memory")

typedef const float* const __attribute__((address_space(4)))* KTab;
struct Frame {
    LAS unsigned char* lds; unsigned char* ws; KTab in; float* out;
    int tid, lane, wave, bid, nblk;
    bf16 *XN, *Y, *Z, *HID, *PB; float *SSQ, *BON;
};
__device__ __forceinline__ bf16* wlayer(const Frame& F, int l) { return (bf16*)(F.ws + WS_W) + (size_t)l * WO_LAYER; }

__device__ __forceinline__ void transpose_item(const float* W, int K, int N, int Npad, bf16* WT, LAS float* scr, int item, int lane) {
    const int nblk = Npad / 32, kb = item / nblk, nb = item % nblk, k0 = 64 * kb, n0 = 32 * nb;
    const int n = n0 + (lane & 31);
#pragma unroll 8
    for (int i = 0; i < 32; ++i) { const int kk = 2 * i + (lane >> 5); scr[kk * 33 + (lane & 31)] = (n < N) ? W[(size_t)(k0 + kk) * N + n] : 0.f; }
    LDS_WAIT();
    const int c = lane & 7;
#pragma unroll
    for (int j = 0; j < 4; ++j) { const int nn = (lane >> 3) + 8 * j; const LAS float* s = scr + (8 * c) * 33 + nn;
        u32x4 o; o.x = pk2(s[0 * 33], s[1 * 33]); o.y = pk2(s[2 * 33], s[3 * 33]); o.z = pk2(s[4 * 33], s[5 * 33]); o.w = pk2(s[6 * 33], s[7 * 33]);
        *(u32x4*)(WT + (size_t)(n0 + nn) * K + k0 + 8 * c) = o; }
    LDS_WAIT();
}
__device__ __forceinline__ void norm_row(const float* xrow, const float* g, bf16* orow, int lane) {
    const f32x4* xp = (const f32x4*)xrow + 2 * lane; const f32x4* gp = (const f32x4*)g + 2 * lane;
    f32x4 v[4]; float s = 0.f;
#pragma unroll
    for (int j = 0; j < 2; ++j) { v[2 * j] = xp[128 * j]; v[2 * j + 1] = xp[128 * j + 1]; }
#pragma unroll
    for (int j = 0; j < 4; ++j) s += (v[j].x * v[j].x + v[j].y * v[j].y) + (v[j].z * v[j].z + v[j].w * v[j].w);
    const float r = rsqrtf(wave_sum(s) * (1.f / DM) + EPS);
#pragma unroll
    for (int j = 0; j < 2; ++j) { const f32x4 ga = gp[128 * j], gb = gp[128 * j + 1]; const f32x4 a = v[2 * j] * r * ga, b = v[2 * j + 1] * r * gb;
        u32x4 o; o.x = pk2(a.x, a.y); o.y = pk2(a.z, a.w); o.z = pk2(b.x, b.y); o.w = pk2(b.z, b.w); *((u32x4*)orow + lane + 64 * j) = o; }
}
__device__ __forceinline__ void phase_prologue(Frame& F) {
    LAS float* scr = (LAS float*)(F.lds + F.wave * 16384);
    const int gw = F.bid * NWAVES + F.wave, NGW = F.nblk * NWAVES;
    constexpr int I_IN = 16 * (NZ / 32), I_OUT = 16 * 32, I_1 = 16 * 128, I_2 = 64 * 32, I_G = 16 * 32, I_P = 4 * 32, I_L = I_IN + I_OUT + I_1 + I_2 + I_G + I_P;
    for (int it = gw; it < 2 * I_L; it += NGW) {
        const int l = it / I_L; int r = it % I_L; bf16* wl = wlayer(F, l);
        if (r < I_IN) { transpose_item(F.in[7] + (size_t)l * DM * DIN, DM, DIN, NZ, wl + WO_IN, scr, r, F.lane); continue; } r -= I_IN;
        if (r < I_OUT) { transpose_item(F.in[8] + (size_t)l * DM * DM, DM, DM, DM, wl + WO_OUT, scr, r, F.lane); continue; } r -= I_OUT;
        if (r < I_1) { transpose_item(F.in[29] + (size_t)l * DM * DFF, DM, DFF, DFF, wl + WO_1, scr, r, F.lane); continue; } r -= I_1;
        if (r < I_2) { transpose_item(F.in[30] + (size_t)l * DFF * DM, DFF, DM, DM, wl + WO_2, scr, r, F.lane); continue; } r -= I_2;
        if (r < I_G) { transpose_item(F.in[32] + (size_t)l * DM * DM, DM, DM, DM, wl + WO_G, scr, r, F.lane); continue; } r -= I_G;
        transpose_item(F.in[31] + (size_t)l * DPLE * DM, DPLE, DM, DM, wl + WO_P, scr, r, F.lane);
    }
    { const size_t ngrp = (size_t)DEPTH * MTOK * DPLE / 8; const f32x4* p4 = (const f32x4*)F.in[1]; u32x4* o = (u32x4*)F.PB;
      for (size_t gi = (size_t)F.bid * NTHR + F.tid; gi < ngrp; gi += (size_t)F.nblk * NTHR) { const f32x4 a = p4[2 * gi], b = p4[2 * gi + 1];
          u32x4 w; w.x = pk2(a.x, a.y); w.y = pk2(a.z, a.w); w.z = pk2(b.x, b.y); w.w = pk2(b.z, b.w); o[gi] = w; } }
    for (int m = gw; m < MTOK; m += NGW) norm_row(F.in[0] + (size_t)m * DM, F.in[2], F.XN + (size_t)m * DM, F.lane);
}

template <bool NORM> __device__ __forceinline__ void phase_rowpass(Frame& F, const float* xin, const bf16* T, const float* gpost, float* xout, bf16* XNo, const float* gpre) {
    const int gw = F.bid * NWAVES + F.wave, NGW = F.nblk * NWAVES, lane = F.lane;
    for (int row = gw; row < MTOK; row += NGW) {
        const u32x4* tp = (const u32x4*)(T + (size_t)row * DM) + lane; const f32x4* xp = (const f32x4*)(xin + (size_t)row * DM) + 2 * lane;
        const f32x4* gp = (const f32x4*)gpost + 2 * lane; f32x4* xo = (f32x4*)(xout + (size_t)row * DM) + 2 * lane;
        float sp = F.SSQ[(size_t)row * 16 + (lane & 15)]; sp = row16_sum(sp);
        const float rt = rsqrtf(sp * (1.f / DM) + EPS);
        f32x4 y[4]; float s2 = 0.f;
#pragma unroll
        for (int j = 0; j < 2; ++j) { const u32x4 t = tp[64 * j]; const f32x4 xa = xp[128 * j], xb = xp[128 * j + 1], ga = gp[128 * j], gb = gp[128 * j + 1];
            f32x4 ta = {bflo(t.x), bfhi(t.x), bflo(t.y), bfhi(t.y)}, tb = {bflo(t.z), bfhi(t.z), bflo(t.w), bfhi(t.w)};
            y[2 * j] = xa + ta * rt * ga; y[2 * j + 1] = xb + tb * rt * gb; xo[128 * j] = y[2 * j]; xo[128 * j + 1] = y[2 * j + 1]; }
        float r = 1.f;
        if (NORM) {
#pragma unroll
            for (int j = 0; j < 4; ++j) s2 += (y[j].x * y[j].x + y[j].y * y[j].y) + (y[j].z * y[j].z + y[j].w * y[j].w);
            r = rsqrtf(wave_sum(s2) * (1.f / DM) + EPS); }
        if (XNo) {
            const f32x4* gq = (const f32x4*)gpre + 2 * lane;
#pragma unroll
            for (int j = 0; j < 2; ++j) { f32x4 a = y[2 * j], b = y[2 * j + 1];
                if (NORM) { a = a * r * gq[128 * j]; b = b * r * gq[128 * j + 1]; }
                u32x4 o; o.x = pk2(a.x, a.y); o.y = pk2(a.z, a.w); o.z = pk2(b.x, b.y); o.w = pk2(b.z, b.w); *((u32x4*)(XNo + (size_t)row * DM) + lane + 64 * j) = o; } }
    }
}

template <int MODE> __device__ __forceinline__ void phase_gemm(Frame& F, const bf16* A, const bf16* Bt, int N, int K, bf16* O, int ldc) {
    pg8::Gemm g{A, Bt, MTOK, N, K}; pg8::StaticOrder S; S.init(MTOK, N, F.nblk, F.bid);
    pg8::EpiOut<MODE> E{O, ldc, F.SSQ};
    pg8::gemm_phase<pg8::EpiOut<MODE>, pg8::StaticOrder, true, true>(F.lds, g, S, E, F.tid);
}

__device__ __forceinline__ void rw_rec_unit(Frame& F, int l, int unit) {
    const int b = unit >> 4, h = (unit >> 1) & 7, half = unit & 1, tid = F.tid, lane = F.lane, wave = F.wave;
    LAS float* Wd = (LAS float*)F.lds; LAS float* NKK = Wd + 2048; LAS float* KKA = Wd + 4096; LAS float* KP = Wd + 6144; LAS float* RR = Wd + 8192;
    LAS float* VV = Wd + 10240; LAS float* OUT = Wd + 11264; LAS float* LW = Wd + 12288; LAS float* LA = Wd + 13312;
    const int c = tid & 63, hc = h * 64 + c;
    const float* mu = F.in[18] + (size_t)l * 1696;
    const float mu_r = mu[hc], mu_k = mu[512 + hc], mu_v = mu[1024 + hc];
    const float w0c = F.in[19][l * 512 + hc], a0c = F.in[21][l * 512 + hc], kkc = F.in[24][l * 512 + hc], kac = F.in[25][l * 512 + hc], rkc = F.in[26][l * 512 + hc];
    float w2c[32], a2c[32];
#pragma unroll
    for (int j = 0; j < 32; ++j) { w2c[j] = F.in[20][((size_t)l * 32 + j) * 512 + hc]; a2c[j] = F.in[22][((size_t)l * 32 + j) * 512 + hc]; }
    const bf16* Zb = F.Z + (size_t)b * SEQ * NZ;
    float S0 = 0.f, S1 = 0.f, S2 = 0.f, S3 = 0.f;
    const int ks = (lane & 15) * 4, vr = wave * 4 + (lane >> 4);
    for (int t0 = 0; t0 < SEQ; t0 += 32) {
        {
            const int tt = tid >> 4, j4 = (tid & 15) * 4, t = t0 + tt;
            const bf16* zr = Zb + (size_t)t * NZ + ZC_WD + j4; const u32x2 cu = *(const u32x2*)zr; u32x2 pv = {0u, 0u}; if (t > 0) pv = *(const u32x2*)(zr - NZ);
            const f32x4 m4 = *(const f32x4*)(mu + 1536 + j4);
            const float c0 = bflo(cu.x), c1 = bfhi(cu.x), c2 = bflo(cu.y), c3 = bfhi(cu.y);
            float v0 = c0 + (bflo(pv.x) - c0) * m4.x, v1 = c1 + (bfhi(pv.x) - c1) * m4.y, v2 = c2 + (bflo(pv.y) - c2) * m4.z, v3 = c3 + (bfhi(pv.y) - c3) * m4.w;
            if (j4 < 32) { *(LAS f32x4*)(LW + tt * 32 + j4) = (f32x4){tanhf(v0), tanhf(v1), tanhf(v2), tanhf(v3)}; }
            else { *(LAS f32x4*)(LA + tt * 32 + j4 - 32) = (f32x4){v0, v1, v2, v3}; }
        }
        __syncthreads();
#pragma unroll 1
        for (int i = 0; i < 4; ++i) {
            const int tt = wave + 8 * i, t = t0 + tt; const bf16* zr = Zb + (size_t)t * NZ;
            const float zr_r = bf2f(zr[ZC_RR + hc]), zr_k = bf2f(zr[ZC_RK + hc]), zr_v = bf2f(zr[ZC_RV + hc]);
            float pr = 0.f, pk = 0.f, pvv = 0.f; if (t > 0) { pr = bf2f(zr[ZC_RR + hc - NZ]); pk = bf2f(zr[ZC_RK + hc - NZ]); pvv = bf2f(zr[ZC_RV + hc - NZ]); }
            const float r = zr_r + (pr - zr_r) * mu_r, k = zr_k + (pk - zr_k) * mu_k, v = zr_v + (pvv - zr_v) * mu_v;
            float lw = w0c, la = a0c;
#pragma unroll
            for (int j4 = 0; j4 < 8; ++j4) { const f32x4 x = *(LAS f32x4*)(LW + tt * 32 + 4 * j4), y = *(LAS f32x4*)(LA + tt * 32 + 4 * j4);
                lw += x.x * w2c[4 * j4] + x.y * w2c[4 * j4 + 1] + x.z * w2c[4 * j4 + 2] + x.w * w2c[4 * j4 + 3];
                la += y.x * a2c[4 * j4] + y.y * a2c[4 * j4 + 1] + y.z * a2c[4 * j4 + 2] + y.w * a2c[4 * j4 + 3]; }
            const float wlog = -softplusf_(-lw) - 0.5f, decay = __expf(-__expf(wlog)), al = sigmoidf_(la);
            const float kkv = k * kkc, nrm = sqrtf(wave_sum(kkv * kkv)), kk = kkv / fmaxf(nrm, 1e-12f);
            const float kp = k * (1.f + (al - 1.f) * kac);
            const float bon = wave_sum(r * kp * rkc);
            if (half == 0 && c == 0) F.BON[((size_t)b * SEQ + t) * 8 + h] = bon;
            Wd[tt * 64 + c] = decay; NKK[tt * 64 + c] = -kk; KKA[tt * 64 + c] = kk * al; KP[tt * 64 + c] = kp; RR[tt * 64 + c] = r;
            if ((c >> 5) == half) VV[tt * 32 + (c & 31)] = v;
        }
        __syncthreads();
#pragma unroll 4
        for (int tt = 0; tt < 32; ++tt) {
            const f32x4 w4 = *(LAS f32x4*)(Wd + tt * 64 + ks), n4 = *(LAS f32x4*)(NKK + tt * 64 + ks), a4 = *(LAS f32x4*)(KKA + tt * 64 + ks), k4 = *(LAS f32x4*)(KP + tt * 64 + ks), r4 = *(LAS f32x4*)(RR + tt * 64 + ks);
            const float vv = VV[tt * 32 + vr];
            float sa = (S0 * n4.x + S1 * n4.y) + (S2 * n4.z + S3 * n4.w); sa = row16_sum(sa);
            S0 = S0 * w4.x + sa * a4.x + vv * k4.x; S1 = S1 * w4.y + sa * a4.y + vv * k4.y; S2 = S2 * w4.z + sa * a4.z + vv * k4.z; S3 = S3 * w4.w + sa * a4.w + vv * k4.w;
            float o = (S0 * r4.x + S1 * r4.y) + (S2 * r4.z + S3 * r4.w); o = row16_sum(o);
            if ((lane & 15) == 0) OUT[tt * 32 + vr] = o;
        }
        __syncthreads();
        { const int tt = tid >> 4, pr = tid & 15; const f32x2 o2 = *(LAS f32x2*)(OUT + tt * 32 + 2 * pr);
          *(unsigned*)(F.Y + ((size_t)b * SEQ + t0 + tt) * DM + 512 + h * 64 + half * 32 + 2 * pr) = pk2(o2.x, o2.y); }
    }
    __syncthreads();
}
__device__ __forceinline__ void phase_rw_epi(Frame& F, int l) {
    const int tid = F.tid, c = tid, h = F.wave;
    LAS float* SG = (LAS float*)F.lds;
    const float* mu = F.in[18] + (size_t)l * 1696; const float mu_v = mu[1024 + c];
    const float lnw = F.in[27][l * 512 + c], lnb = F.in[28][l * 512 + c];
    float g2c[96];
#pragma unroll
    for (int j = 0; j < 96; ++j) g2c[j] = F.in[23][((size_t)l * 96 + j) * 512 + c];
    for (int u = F.bid; u < MTOK / 32; u += F.nblk) {
        const int tok0 = u * 32;
        __syncthreads();
#pragma unroll
        for (int i = 0; i < 6; ++i) { const int e = tid + 512 * i, tt = e / 96, j = e % 96, tok = tok0 + tt; const bf16* zr = F.Z + (size_t)tok * NZ + ZC_GD + j;
            const float cu = bf2f(zr[0]); float pv = 0.f; if ((tok & (SEQ - 1)) != 0) pv = bf2f(zr[-NZ]);
            SG[e] = sigmoidf_(cu + (pv - cu) * mu[1600 + j]); }
        __syncthreads();
#pragma unroll 1
        for (int tt = 0; tt < 32; ++tt) { const int tok = tok0 + tt; bf16* yp = F.Y + (size_t)tok * DM + 512 + c;
            const float o = bf2f(*yp); const float mean = wave_sum(o) * (1.f / 64.f), d = o - mean, var = wave_sum(d * d) * (1.f / 64.f);
            const float on = d * rsqrtf(var + 64e-5f) * lnw + lnb;
            const bf16* zr = F.Z + (size_t)tok * NZ + ZC_RV + c; const float cu = bf2f(zr[0]); float pv = 0.f; if ((tok & (SEQ - 1)) != 0) pv = bf2f(zr[-NZ]);
            const float v = cu + (pv - cu) * mu_v, bon = F.BON[(size_t)tok * 8 + h];
            float g = 0.f;
#pragma unroll
            for (int j4 = 0; j4 < 24; ++j4) { const f32x4 s = *(LAS f32x4*)(SG + tt * 96 + 4 * j4); g += s.x * g2c[4 * j4] + s.y * g2c[4 * j4 + 1] + s.z * g2c[4 * j4 + 2] + s.w * g2c[4 * j4 + 3]; }
            *yp = f2bf((on + bon * v) * g); }
    }
}

__device__ __forceinline__ float wave_scan_add(float v, int lane) {
#pragma unroll
    for (int o = 1; o < 64; o <<= 1) { const float t = __shfl_up(v, o); if (lane >= o) v += t; }
    return v;
}
__device__ __forceinline__ float wave_scan_max(float v, int lane) {
#pragma unroll
    for (int o = 1; o < 64; o <<= 1) { const float t = __shfl_up(v, o); if (lane >= o) v = fmaxf(v, t); }
    return v;
}
__device__ __forceinline__ void mlstm_unit(Frame& F, int l, int unit) {
    const int b = unit >> 2, h = unit & 3, tid = F.tid, lane = F.lane, wave = F.wave, fr = lane & 15, fq = lane >> 4;
    constexpr int LP = 72;
    LAS bf16* Qs = (LAS bf16*)F.lds; LAS bf16* Ks = Qs + 64 * LP; LAS bf16* VT = Ks + 64 * LP; LAS bf16* WKT = VT + 64 * LP; LAS bf16* Ps = WKT + 64 * LP;
    LAS bf16* Cb0 = Ps + 64 * LP; LAS bf16* Cb1 = Cb0 + 64 * LP; LAS bf16* NB0 = Cb1 + 64 * LP; LAS bf16* NB1 = NB0 + 16 * LP;
    LAS float* Fv = (LAS float*)(NB1 + 16 * LP); LAS float* Gv = Fv + 64; LAS float* MROW = Gv + 64; LAS float* WINT = MROW + 64; LAS float* WL = WINT + 64; LAS float* SC = WL + 64;
    const float bias_i = F.in[9][l * 8 + h], bias_f = F.in[9][l * 8 + 4 + h];
    for (int e = tid; e < (2 * 64 + 2 * 16) * LP / 2; e += NTHR) ((LAS unsigned*)Cb0)[e] = 0u;
    f32x4 Cacc[4]; float nst = 0.f, m_prev = 0.f;
#pragma unroll
    for (int ct = 0; ct < 4; ++ct) Cacc[ct] = (f32x4){0.f, 0.f, 0.f, 0.f};
    const bf16* Zb = F.Z + (size_t)b * SEQ * NZ;
    __syncthreads();
    for (int ch = 0; ch < SEQ / 64; ++ch) {
        const int t0 = ch * 64; LAS bf16* Cbc = (ch & 1) ? Cb1 : Cb0; LAS bf16* Cbn = (ch & 1) ? Cb0 : Cb1; LAS bf16* NBc = (ch & 1) ? NB1 : NB0; LAS bf16* NBn = (ch & 1) ? NB0 : NB1;
        if (wave == 0) {
            const bf16* zr = Zb + (size_t)(t0 + lane) * NZ; const float fp = bf2f(zr[ZC_F + h]) + bias_f, ig = bf2f(zr[ZC_I + h]) + bias_i;
            const float lf = -softplusf_(-fp); const float Fc = wave_scan_add(lf, lane); const float g = ig - Fc; const float pm = wave_scan_max(g, lane);
            const float mrow = Fc + fmaxf(m_prev, pm); const float Ftot = __shfl(Fc, 63), gmax = __shfl(pm, 63);
            const float m_new = fmaxf(Ftot + m_prev, Ftot + gmax);
            Fv[lane] = Fc - mrow; Gv[lane] = g; MROW[lane] = mrow; WINT[lane] = __expf(Fc + m_prev - mrow); WL[lane] = __expf(Ftot + g - m_new);
            if (lane == 0) SC[0] = __expf(Ftot + m_prev - m_new);
            m_prev = m_new;
        }
        __syncthreads();
        {
            const int row = tid >> 3, c8 = (tid & 7) * 8; const bf16* zr = Zb + (size_t)(t0 + row) * NZ + h * 64 + c8;
            const u32x4 q8 = *(const u32x4*)(zr + ZC_Q), k8 = *(const u32x4*)(zr + ZC_K), v8 = *(const u32x4*)(zr + ZC_V);
            *(LAS u32x4*)(Qs + row * LP + c8) = q8; *(LAS u32x4*)(Ks + row * LP + c8) = k8;
            const float wl = WL[row]; const unsigned kw[4] = {k8.x, k8.y, k8.z, k8.w}, vw[4] = {v8.x, v8.y, v8.z, v8.w};
#pragma unroll
            for (int e = 0; e < 4; ++e) { WKT[(c8 + 2 * e) * LP + row] = f2bf(bflo(kw[e]) * wl); WKT[(c8 + 2 * e + 1) * LP + row] = f2bf(bfhi(kw[e]) * wl);
                VT[(c8 + 2 * e) * LP + row] = (bf16)(vw[e] & 0xffffu); VT[(c8 + 2 * e + 1) * LP + row] = (bf16)(vw[e] >> 16); }
        }
        __syncthreads();
        if (wave < 4) {
            const int jb = 16 * wave; bf16x8 aq[2];
#pragma unroll
            for (int k2 = 0; k2 < 2; ++k2) aq[k2] = *(LAS bf16x8*)(Qs + (jb + fr) * LP + 32 * k2 + 8 * fq);
            f32x4 aS[4], aN[4], aQ = {0.f, 0.f, 0.f, 0.f};
#pragma unroll
            for (int ct = 0; ct < 4; ++ct) { aS[ct] = (f32x4){0.f, 0.f, 0.f, 0.f}; aN[ct] = (f32x4){0.f, 0.f, 0.f, 0.f};
#pragma unroll
                for (int k2 = 0; k2 < 2; ++k2) { const bf16x8 bk = *(LAS bf16x8*)(Ks + (16 * ct + fr) * LP + 32 * k2 + 8 * fq), bc = *(LAS bf16x8*)(Cbc + (16 * ct + fr) * LP + 32 * k2 + 8 * fq);
                    aS[ct] = __builtin_amdgcn_mfma_f32_16x16x32_bf16(aq[k2], bk, aS[ct], 0, 0, 0); aN[ct] = __builtin_amdgcn_mfma_f32_16x16x32_bf16(aq[k2], bc, aN[ct], 0, 0, 0); } }
#pragma unroll
            for (int k2 = 0; k2 < 2; ++k2) { const bf16x8 bn = *(LAS bf16x8*)(NBc + fr * LP + 32 * k2 + 8 * fq); aQ = __builtin_amdgcn_mfma_f32_16x16x32_bf16(aq[k2], bn, aQ, 0, 0, 0); }
            float fj[4], wi[4], mr[4], den[4];
#pragma unroll
            for (int r = 0; r < 4; ++r) { const int j = jb + 4 * fq + r; fj[r] = Fv[j]; wi[r] = WINT[j] * 0.125f; mr[r] = MROW[j]; den[r] = 0.f; }
#pragma unroll
            for (int ct = 0; ct < 4; ++ct) { const int s = 16 * ct + fr; const float gs = Gv[s];
#pragma unroll
                for (int r = 0; r < 4; ++r) { const int j = jb + 4 * fq + r; const float p = (s <= j) ? aS[ct][r] * 0.125f * __expf(fj[r] + gs) : 0.f; den[r] += p; Ps[j * LP + s] = f2bf(p); } }
            LDS_WAIT();
            f32x4 aP[4];
            bf16x8 ap[2];
#pragma unroll
            for (int k2 = 0; k2 < 2; ++k2) ap[k2] = *(LAS bf16x8*)(Ps + (jb + fr) * LP + 32 * k2 + 8 * fq);
#pragma unroll
            for (int ct = 0; ct < 4; ++ct) { aP[ct] = (f32x4){0.f, 0.f, 0.f, 0.f};
#pragma unroll
                for (int k2 = 0; k2 < 2; ++k2) { const bf16x8 bv = *(LAS bf16x8*)(VT + (16 * ct + fr) * LP + 32 * k2 + 8 * fq); aP[ct] = __builtin_amdgcn_mfma_f32_16x16x32_bf16(ap[k2], bv, aP[ct], 0, 0, 0); } }
            float ssq[4];
#pragma unroll
            for (int r = 0; r < 4; ++r) { den[r] = row16_sum(den[r]) + wi[r] * aQ[r]; const float dd = fmaxf(fabsf(den[r]), __expf(-mr[r])); const float inv = 1.f / dd; float s2 = 0.f;
#pragma unroll
                for (int ct = 0; ct < 4; ++ct) { const float hv = (aP[ct][r] + wi[r] * aN[ct][r]) * inv; aP[ct][r] = hv; s2 += hv * hv; }
                ssq[r] = rsqrtf(row16_sum(s2) * (1.f / 64.f) + EPS); }
#pragma unroll
            for (int ct = 0; ct < 4; ++ct) { const int v = 16 * ct + fr; const float hn = F.in[10][l * 256 + h * 64 + v];
#pragma unroll
                for (int r = 0; r < 4; ++r) { const size_t tok = (size_t)b * SEQ + t0 + jb + 4 * fq + r; const float og = bf2f(F.Z[tok * NZ + ZC_O + h * 64 + v]);
                    F.Y[tok * DM + h * 64 + v] = f2bf(aP[ct][r] * ssq[r] * hn * sigmoidf_(og)); } }
        } else {
            const int vb = 16 * (wave - 4); const float ac = SC[0]; bf16x8 av[2];
#pragma unroll
            for (int k2 = 0; k2 < 2; ++k2) av[k2] = *(LAS bf16x8*)(VT + (vb + fr) * LP + 32 * k2 + 8 * fq);
#pragma unroll
            for (int ct = 0; ct < 4; ++ct) { Cacc[ct] = Cacc[ct] * ac;
#pragma unroll
                for (int k2 = 0; k2 < 2; ++k2) { const bf16x8 bw = *(LAS bf16x8*)(WKT + (16 * ct + fr) * LP + 32 * k2 + 8 * fq); Cacc[ct] = __builtin_amdgcn_mfma_f32_16x16x32_bf16(av[k2], bw, Cacc[ct], 0, 0, 0); }
#pragma unroll
                for (int r = 0; r < 4; ++r) Cbn[(vb + 4 * fq + r) * LP + 16 * ct + fr] = f2bf(Cacc[ct][r]); }
            if (wave == 4) { float ns = 0.f;
#pragma unroll
                for (int k8 = 0; k8 < 8; ++k8) { const u32x4 w = *(LAS u32x4*)(WKT + lane * LP + 8 * k8); ns += (bflo(w.x) + bfhi(w.x)) + (bflo(w.y) + bfhi(w.y)) + (bflo(w.z) + bfhi(w.z)) + (bflo(w.w) + bfhi(w.w)); }
                nst = ac * nst + ns; const bf16 nb = f2bf(nst);
#pragma unroll
                for (int r = 0; r < 16; ++r) NBn[r * LP + lane] = nb; }
        }
        __syncthreads();
    }
}

__device__ __forceinline__ float gelu_tanh(float x) { const float u = 0.7978845608028654f * (x + 0.044715f * x * x * x); return 0.5f * x * (1.f + tanhf(u)); }
__device__ __forceinline__ void lru_unit(Frame& F, int l, int unit) {
    const int b = unit >> 2, blk = unit & 3, tid = F.tid, lane = F.lane, wave = F.wave, fr = lane & 15, fq = lane >> 4;
    constexpr int LP = 72;
    LAS bf16* WrT = (LAS bf16*)F.lds; LAS bf16* WiT = WrT + 64 * LP; LAS bf16* Xc = WiT + 64 * LP;
    LAS float* XcF = (LAS float*)(Xc + 64 * LP); LAS float* GR = XcF + 4096; LAS float* GI = GR + 4096;
    __syncthreads();
    for (int e = tid; e < 4096; e += NTHR) { const int d = e >> 6, ee = e & 63; const size_t wi = (((size_t)l * 4 + blk) * 64 + d) * 64 + ee;
        WrT[ee * LP + d] = f2bf(F.in[13][wi]); WiT[ee * LP + d] = f2bf(F.in[15][wi]); }
    const int ch = tid & 63, tg = tid >> 6, cg_ = blk * 64 + ch;
    float cw[4];
#pragma unroll
    for (int j = 0; j < 4; ++j) cw[j] = F.in[11][((size_t)l * 4 + j) * 256 + cg_];
    const float cb = F.in[12][l * 256 + cg_], sp = softplusf_(-F.in[17][l * 256 + cg_]);
    const bf16* Zb = F.Z + (size_t)b * SEQ * NZ;
    float hst = 0.f;
    __syncthreads();
    for (int t0 = 0; t0 < SEQ; t0 += 64) {
        {   float xv[11];
#pragma unroll
            for (int k = 0; k < 11; ++k) { const int t = t0 + tg * 8 - 3 + k; xv[k] = (t >= 0) ? bf2f(Zb[(size_t)t * NZ + ZC_XB + cg_]) : 0.f; }
#pragma unroll
            for (int i = 0; i < 8; ++i) { const int tt = tg * 8 + i; const float xc = cb + (cw[0] * xv[i] + cw[1] * xv[i + 1]) + (cw[2] * xv[i + 2] + cw[3] * xv[i + 3]);
                Xc[tt * LP + ch] = f2bf(xc); XcF[tt * 64 + ch] = xc; } }
        __syncthreads();
        {   const int tb = 16 * (wave & 3), gate = wave >> 2; LAS bf16* WT = gate ? WiT : WrT; LAS float* G = gate ? GI : GR; const float* bias = (gate ? F.in[16] : F.in[14]) + l * 256 + blk * 64;
            bf16x8 ax[2];
#pragma unroll
            for (int k2 = 0; k2 < 2; ++k2) ax[k2] = *(LAS bf16x8*)(Xc + (tb + fr) * LP + 32 * k2 + 8 * fq);
#pragma unroll
            for (int ct = 0; ct < 4; ++ct) { f32x4 acc = {0.f, 0.f, 0.f, 0.f};
#pragma unroll
                for (int k2 = 0; k2 < 2; ++k2) { const bf16x8 bw = *(LAS bf16x8*)(WT + (16 * ct + fr) * LP + 32 * k2 + 8 * fq); acc = __builtin_amdgcn_mfma_f32_16x16x32_bf16(ax[k2], bw, acc, 0, 0, 0); }
                const float bs = bias[16 * ct + fr];
#pragma unroll
                for (int r = 0; r < 4; ++r) G[(tb + 4 * fq + r) * 64 + 16 * ct + fr] = sigmoidf_(acc[r] + bs); } }
        __syncthreads();
#pragma unroll
        for (int i = 0; i < 8; ++i) { const int e = (tg * 8 + i) * 64 + ch; const float r = GR[e], ig = GI[e], xc = XcF[e];
            const float la = -8.0f * r * sp, a = __expf(la), u = sqrtf(-expm1f(2.f * la)) * (ig * xc); GR[e] = a; GI[e] = u; }
        __syncthreads();
        if (wave == 0) {
#pragma unroll 8
            for (int tt = 0; tt < 64; ++tt) { hst = GR[tt * 64 + lane] * hst + GI[tt * 64 + lane]; XcF[tt * 64 + lane] = hst; } }
        __syncthreads();
#pragma unroll
        for (int i = 0; i < 8; ++i) { const int tt = tg * 8 + i; const size_t tok = (size_t)b * SEQ + t0 + tt; const float gb = bf2f(F.Z[tok * NZ + ZC_GB + cg_]);
            F.Y[tok * DM + 256 + cg_] = f2bf(XcF[tt * 64 + ch] * gelu_tanh(gb)); }
        __syncthreads();
    }
}
__device__ __forceinline__ void phase_mixers(Frame& F, int l) {
    for (int u = F.bid; u < 192; u += F.nblk) {
        if (u < 128) rw_rec_unit(F, l, u); else if (u < 160) mlstm_unit(F, l, u - 128); else lru_unit(F, l, u - 160);
    }
}
constexpr int PH_PER_LAYER = 11, N_PHASES = 1 + DEPTH * PH_PER_LAYER;
#ifndef PHM
#define PHM 1023
#endif
#ifndef MK_ONE_LAUNCH
#define MK_ONE_LAUNCH 1
#endif

__global__ void __launch_bounds__(NTHR, 2) mega(Args a) {
    extern __shared__ __attribute__((aligned(16))) unsigned char lds_raw[];
    Frame F;
    F.lds = (LAS unsigned char*)lds_raw; F.ws = a.ws; F.out = a.out;
    F.XN = (bf16*)(a.ws + WS_XN); F.Y = (bf16*)(a.ws + WS_Y); F.Z = (bf16*)(a.ws + WS_ZH); F.HID = (bf16*)(a.ws + WS_ZH); F.PB = (bf16*)(a.ws + WS_PB);
    F.SSQ = (float*)(a.ws + WS_SSQ); F.BON = (float*)(a.ws + WS_BON);
    for (int ph = a.ph_lo; ph < a.ph_hi; ++ph) {
        if (ph > a.ph_lo) cg::this_grid().sync();
        { auto ka = __builtin_amdgcn_kernarg_segment_ptr(); asm volatile("" : "+s"(ka)); F.in = (KTab)ka; }
        { int tv = threadIdx.x, bv = blockIdx.x, gv = gridDim.x; asm volatile("" : "+v"(tv), "+s"(bv), "+s"(gv));
          F.tid = tv; F.lane = tv & 63; F.wave = __builtin_amdgcn_readfirstlane(tv >> 6); F.bid = bv; F.nblk = gv; }
        if (ph == 0) { if (PHM & 1) phase_prologue(F); continue; }
        const int l = (ph - 1) / PH_PER_LAYER, k = (ph - 1) % PH_PER_LAYER;
        bf16* wl = wlayer(F, l);
        if ((PHM & 2) && (k == 0 || k == 8)) {
            const bf16* A = (k == 0) ? F.XN : F.PB + (size_t)l * MTOK * DPLE; const bf16* Bt = (k == 0) ? wl + WO_IN : wl + WO_P;
            const int N = (k == 0) ? NZ : DM, K = (k == 0) ? DM : DPLE; bf16* O = (k == 0) ? F.Z : F.Y;
            phase_gemm<0>(F, A, Bt, N, K, O, N);
        } else if ((PHM & 4) && k == 1) { phase_mixers(F, l);
        } else if ((PHM & 8) && k == 2) { phase_rw_epi(F, l);
        } else if ((PHM & 16) && (k == 3 || k == 6)) {
            const bf16* A = (k == 3) ? F.Y : F.HID; const bf16* Bt = (k == 3) ? wl + WO_OUT : wl + WO_2; const int K = (k == 3) ? DM : DFF;
            phase_gemm<2>(F, A, Bt, DM, K, F.XN, DM);
        } else if ((PHM & 32) && k == 4) { phase_rowpass<true>(F, l == 0 ? F.in[0] : a.out, F.XN, F.in[3] + l * DM, a.out, F.XN, F.in[4] + l * DM);
        } else if ((PHM & 64) && k == 5) { phase_gemm<1>(F, F.XN, wl + WO_1, DFF, DM, F.HID, DFF);
        } else if ((PHM & 128) && k == 7) { phase_rowpass<false>(F, a.out, F.XN, F.in[5] + l * DM, a.out, F.XN, nullptr);
        } else if ((PHM & 256) && k == 9) { phase_gemm<3>(F, F.XN, wl + WO_G, DM, DM, F.Y, DM);
        } else if ((PHM & 512) && k == 10) { phase_rowpass<true>(F, a.out, F.Y, F.in[6] + l * DM, a.out, (l + 1 < DEPTH) ? F.XN : nullptr, F.in[2] + (l + 1 < DEPTH ? (l + 1) * DM : 0)); }
    }
}

extern "C" void kernel_launch(void* const* d_in, const int* in_sizes, int n_in, void* d_out, int out_size, void* d_ws, size_t ws_size, hipStream_t stream) {
    static int grid = 0;
    if (grid == 0) {
        if (n_in != 33 || out_size != MTOK * DM || ws_size < WS_END) { fprintf(stderr, "kernel_launch: unexpected shapes (n_in %d out %d ws %zu)\n", n_in, out_size, ws_size); grid = -1; return; }
        if (hipFuncSetAttribute((const void*)mega, hipFuncAttributeMaxDynamicSharedMemorySize, LDS_BYTES) != hipSuccess) { fprintf(stderr, "kernel_launch: hipFuncSetAttribute failed\n"); grid = -1; return; }
        int dev = 0, cus = 0, per_cu = 0;
        (void)hipGetDevice(&dev); (void)hipDeviceGetAttribute(&cus, hipDeviceAttributeMultiprocessorCount, dev);
        (void)hipOccupancyMaxActiveBlocksPerMultiprocessor(&per_cu, (const void*)mega, NTHR, LDS_BYTES);
        if (per_cu < 1) { fprintf(stderr, "kernel_launch: occupancy query says %d blocks per CU\n", per_cu); per_cu = 1; }
        (void)hipGetLastError();
        grid = cus;
        if (grid != 256) fprintf(stderr, "kernel_launch: note: %d CUs\n", grid);
    }
    if (grid < 0) return;
    Args a{};
    for (int i = 0; i < 33; ++i) a.in[i] = (const float*)d_in[i];
    a.out = (float*)d_out; a.ws = (unsigned char*)d_ws;
#if MK_ONE_LAUNCH
    a.ph_lo = 0; a.ph_hi = N_PHASES;
    void* params[] = {&a};
    hipError_t e = hipLaunchCooperativeKernel((const void*)mega, dim3(grid), dim3(NTHR), params, LDS_BYTES, stream);
    if (e != hipSuccess) fprintf(stderr, "kernel_launch: cooperative launch failed: %s\n", hipGetErrorString(e));
#else
    for (int ph = 0; ph < N_PHASES; ++ph) { a.ph_lo = ph; a.ph_hi = ph + 1; hipLaunchKernelGGL(mega, dim3(grid), dim3(NTHR), LDS_BYTES, stream, a); }
#endif
}
```

```cpp
#include <hip/hip_runtime.h>
#include <hip/hip_cooperative_groups.h>
#include <cstdio>
#include <cstdint>
namespace cg = cooperative_groups;

constexpr int BATCH = 8, SEQ = 4096, DM = 1024, DEPTH = 2, DPLE = 256, DFF = 4096;
constexpr int MTOK = BATCH * SEQ;
constexpr int NZ = 3328;
constexpr int ZC_Q = 0, ZC_K = 256, ZC_V = 512, ZC_O = 768, ZC_I = 1024, ZC_F = 1028, ZC_XB = 1032, ZC_GB = 1288;
constexpr int ZC_RW = 1544, ZC_RR = 1544, ZC_RK = 2056, ZC_RV = 2568, ZC_WD = 3080, ZC_AD = 3112, ZC_GD = 3144, DIN = 3240;
constexpr float EPS = 1e-6f;
namespace pg8 {
#define PG8_LAS __attribute__((address_space(3)))
typedef unsigned short bf16_t;
typedef short bf16x8 __attribute__((ext_vector_type(8)));
typedef float f32x4 __attribute__((ext_vector_type(4)));
typedef unsigned u32x4 __attribute__((ext_vector_type(4)));
constexpr int BM = 256, BK = 64, HALF = 128, HTB = HALF * BK * 2  , STAGE_BYTES = 8 * HTB, NXCD = 8, WGM = 8;

__host__ __device__ __forceinline__ int lds_byte(int r, int c) { const int st = (r >> 4) * 2 + (c >> 5), rr = r & 15, cc = c & 31, ob = rr * 64 + cc * 2; return st * 1024 + (ob ^ (((ob >> 9) & 1) << 5)); }
__host__ __device__ __forceinline__ void stage_rc(int b, int& R, int& C) { const int st = b / 1024, sb = b % 1024, swz = sb ^ (((sb >> 9) & 1) << 5); R = (st >> 1) * 16 + swz / 64; C = (st & 1) * 32 + (swz % 64) / 2; }
__host__ __device__ __forceinline__ int perm32(int rho) { const int n = rho >> 4, i = rho & 15; return 8 * (i >> 2) + 4 * n + (i & 3); }

struct Unit { int pm, pn; };
struct Gemm { const bf16_t* A; const bf16_t* Bt; int M, N, K; };

struct StaticOrder {
    int nM, nN, nwg, G, c;
    __host__ __device__ void init(int M, int N, int G_, int c_) { nM = M / BM; nN = N / BM; nwg = nM * nN; G = G_; c = c_; }
    __host__ __device__ bool next(int i, Unit& u) const {
        const long L = (long)i * G + c; if (L >= nwg) return false;
        int wgid = (int)L; { const int q = nwg / NXCD, r = nwg % NXCD, xcd = wgid % NXCD, off = wgid / NXCD; wgid = (xcd < r ? xcd * (q + 1) : r * (q + 1) + (xcd - r) * q) + off; }
        const int nig = WGM * nN, gid = wgid / nig, fm = gid * WGM, gsz = (nM - fm) < WGM ? (nM - fm) : WGM;
        u.pm = fm + ((wgid % nig) % gsz); u.pn = (wgid % nig) / gsz; return true;
    }
    __device__ __forceinline__ void a_ready(const Unit&) const {}
    __device__ __forceinline__ void done(const Unit&) const {}
};

__device__ __forceinline__ unsigned cvt_pk_bf16(float lo, float hi) { unsigned r; asm volatile("v_cvt_pk_bf16_f32 %0, %1, %2" : "=v"(r) : "v"(lo), "v"(hi)); return r; }
__device__ __forceinline__ float bfl(unsigned w) { return __uint_as_float(w << 16); }
__device__ __forceinline__ float bfh(unsigned w) { return __uint_as_float(w & 0xffff0000u); }
__device__ __forceinline__ float sigm(float x) { return __builtin_amdgcn_rcpf(1.0f + __expf(-x)); }
template <int MODE> struct EpiOut {
    static constexpr bool PERM = true, AFTER_DRAIN = false;
    bf16_t* O; int ldc; float* ssq;
    __device__ __forceinline__ void operator()(const f32x4 (&acc)[2][2][4][2], const Unit& u, int wr, int wc, int fr, int fq) const {
        const int row0 = u.pm * BM + wr * 64 + fr, col0 = u.pn * BM + wc * 32 + 8 * fq;
#pragma unroll
        for (int ai = 0; ai < 2; ++ai)
#pragma unroll
            for (int m = 0; m < 4; ++m) { const int row = row0 + ai * HALF + m * 16; bf16_t* rowp = O + (size_t)row * ldc + col0; float ss = 0.f;
#pragma unroll
                for (int bj = 0; bj < 2; ++bj) { f32x4 v0 = acc[ai][bj][m][0], v1 = acc[ai][bj][m][1];
                    if (MODE == 1) {
#pragma unroll
                        for (int e = 0; e < 4; ++e) { const float a = fmaxf(v0[e], 0.f), b = fmaxf(v1[e], 0.f); v0[e] = a * a; v1[e] = b * b; } }
                    if (MODE == 3) { const u32x4 pp = *(const u32x4*)(rowp + bj * HALF);
                        v0[0] = sigm(v0[0]) * bfl(pp.x); v0[1] = sigm(v0[1]) * bfh(pp.x); v0[2] = sigm(v0[2]) * bfl(pp.y); v0[3] = sigm(v0[3]) * bfh(pp.y);
                        v1[0] = sigm(v1[0]) * bfl(pp.z); v1[1] = sigm(v1[1]) * bfh(pp.z); v1[2] = sigm(v1[2]) * bfl(pp.w); v1[3] = sigm(v1[3]) * bfh(pp.w); }
                    if (MODE >= 2) ss += (v0[0] * v0[0] + v0[1] * v0[1]) + (v0[2] * v0[2] + v0[3] * v0[3]) + (v1[0] * v1[0] + v1[1] * v1[1]) + (v1[2] * v1[2] + v1[3] * v1[3]);
                    u32x4 w; w.x = cvt_pk_bf16(v0[0], v0[1]); w.y = cvt_pk_bf16(v0[2], v0[3]); w.z = cvt_pk_bf16(v1[0], v1[1]); w.w = cvt_pk_bf16(v1[2], v1[3]);
                    *(u32x4*)(rowp + bj * HALF) = w; }
                if (MODE >= 2) { ss += __shfl_xor(ss, 16); ss += __shfl_xor(ss, 32); if (fq == 0) ssq[(size_t)row * 16 + u.pn * 4 + wc] = ss; } }
    }
};

template <class Epi, class Sched, bool ALIGN_EPI = false, bool SP2 = false>
__device__ __forceinline__ void gemm_phase(PG8_LAS unsigned char* lds, const Gemm g, const Sched& S, const Epi& E, const int tid) {
    const int wid = __builtin_amdgcn_readfirstlane(tid >> 6), lane = tid & 63, wr = wid >> 2, wc = wid & 3, fr = lane & 15, fq = lane >> 4;
    const int K = g.K, nt = K / BK;
    unsigned voffA[2], voffB[2];
#pragma unroll
    for (int i = 0; i < 2; ++i) { int R, C; stage_rc(tid * 16 + i * 8192, R, C); const int Rb = Epi::PERM ? ((R & ~31) + perm32(R & 31)) : R;
        voffA[i] = (unsigned)(R * K + C) * 2u; voffB[i] = (unsigned)(Rb * K + C) * 2u; }
    const size_t kstep = (size_t)(BK * 2);
    const size_t hstep = (size_t)HALF * K * 2;
    const size_t tstep = 2 * hstep;
    const unsigned ldsw = (unsigned)wid * 1024u;
    const int aoff = lds_byte(wr * 64 + fr, fq * 8), boff = lds_byte(wc * 32 + fr, fq * 8);
#define PG8_SA(b, h) (((b) * 2 + (h)) * HTB)
#define PG8_SB(b, h) ((4 + (b) * 2 + (h)) * HTB)
#define PG8_STAGE(bufoff, gbase, voff) do { _Pragma("unroll") for (int _i = 0; _i < 2; ++_i) \
        __builtin_amdgcn_global_load_lds((const unsigned*)((const char*)(gbase) + (voff)[_i]), (PG8_LAS unsigned*)(lds + (bufoff) + ldsw + _i * 8192), 16, 0, 0); } while (0)
#define PG8_LDA(dst, b, h) do { _Pragma("unroll") for (int m = 0; m < 4; ++m) _Pragma("unroll") for (int k = 0; k < 2; ++k) dst[m][k] = *(const PG8_LAS bf16x8*)(lds + PG8_SA(b, h) + aoff + m * 2048 + k * 1024); } while (0)
#define PG8_LDB(dst, b, h) do { _Pragma("unroll") for (int n = 0; n < 2; ++n) _Pragma("unroll") for (int k = 0; k < 2; ++k) dst[n][k] = *(const PG8_LAS bf16x8*)(lds + PG8_SB(b, h) + boff + n * 2048 + k * 1024); } while (0)
#define PG8_MMA(ai, bj, At, Bt) do { __builtin_amdgcn_s_setprio(1); _Pragma("unroll") for (int m = 0; m < 4; ++m) _Pragma("unroll") for (int n = 0; n < 2; ++n) _Pragma("unroll") for (int k = 0; k < 2; ++k) \
        acc[ai][bj][m][n] = __builtin_amdgcn_mfma_f32_16x16x32_bf16(Bt[n][k], At[m][k], acc[ai][bj][m][n], 0, 0, 0); __builtin_amdgcn_s_setprio(0); } while (0)
#define PG8_WAIT_V(n) asm volatile("s_waitcnt vmcnt(" #n ")" ::: "memory")
#define PG8_WAIT_L(n) asm volatile("s_waitcnt lgkmcnt(" #n ")" ::: "memory")
#define PG8_BAR __builtin_amdgcn_s_barrier()
#define PG8_SCHED __builtin_amdgcn_sched_barrier(0)
    Unit cur, nxt; int ui = 0;
    if (!S.next(0, cur)) return;
    f32x4 acc[2][2][4][2];
#pragma unroll
    for (int a = 0; a < 2; ++a)
#pragma unroll
        for (int b = 0; b < 2; ++b)
#pragma unroll
            for (int m = 0; m < 4; ++m)
#pragma unroll
                for (int n = 0; n < 2; ++n) acc[a][b][m][n] = (f32x4){0.f, 0.f, 0.f, 0.f};
    bf16x8 At[4][2], B0[2][2], B1[2][2];
    const char* cA = (const char*)g.A + (size_t)cur.pm * tstep; const char* cB = (const char*)g.Bt + (size_t)cur.pn * tstep;
    S.a_ready(cur);
    if constexpr (SP2) {
        PG8_STAGE(PG8_SB(0, 0), cB, voffB); PG8_STAGE(PG8_SB(0, 1), cB + hstep, voffB); PG8_STAGE(PG8_SA(0, 0), cA, voffA); PG8_STAGE(PG8_SA(0, 1), cA + hstep, voffA);
        if (wr == 1) PG8_BAR;
        PG8_WAIT_V(2); PG8_BAR;
        PG8_STAGE(PG8_SB(1, 0), cB + kstep, voffB); PG8_STAGE(PG8_SA(1, 0), cA + kstep, voffA); PG8_STAGE(PG8_SB(1, 1), cB + hstep + kstep, voffB);
        PG8_WAIT_V(6); PG8_BAR;
    } else {
        PG8_STAGE(PG8_SB(0, 0), cB, voffB); PG8_STAGE(PG8_SA(0, 0), cA, voffA); PG8_STAGE(PG8_SB(0, 1), cB + hstep, voffB); PG8_STAGE(PG8_SA(0, 1), cA + hstep, voffA);
        if (wr == 1) PG8_BAR;
        PG8_WAIT_V(4); PG8_BAR;
        PG8_STAGE(PG8_SB(1, 0), cB + kstep, voffB); PG8_STAGE(PG8_SA(1, 0), cA + kstep, voffA); PG8_STAGE(PG8_SB(1, 1), cB + hstep + kstep, voffB);
        PG8_WAIT_V(6); PG8_BAR;
    }
    for (;;) {
        const bool has_next = S.next(ui + 1, nxt);
        const char* nA = has_next ? (const char*)g.A + (size_t)nxt.pm * tstep : cA; const char* nB = has_next ? (const char*)g.Bt + (size_t)nxt.pn * tstep : cB;
        for (int t = 0; t < nt; t += 2) {
            const bool last = (t == nt - 2);
            const char* a1 = cA + (size_t)(t + 1) * kstep;
            const char* a2 = last ? nA : cA + (size_t)(t + 2) * kstep; const char* b2 = last ? nB : cB + (size_t)(t + 2) * kstep;
            const char* a3 = a2 + kstep; const char* b3 = b2 + kstep;
            if (last && has_next) S.a_ready(nxt);
            if constexpr (SP2) {
            PG8_LDB(B0, 0, 0); PG8_LDB(B1, 0, 1); PG8_SCHED; PG8_LDA(At, 0, 0); PG8_STAGE(PG8_SA(1, 1), a1 + hstep, voffA);
            PG8_WAIT_V(8); PG8_WAIT_L(0); PG8_BAR; PG8_MMA(0, 0, At, B0); PG8_MMA(0, 1, At, B1); PG8_BAR; PG8_SCHED;
            PG8_LDA(At, 0, 1); PG8_STAGE(PG8_SB(0, 0), b2, voffB); PG8_STAGE(PG8_SB(0, 1), b2 + hstep, voffB); PG8_STAGE(PG8_SA(0, 0), a2, voffA);
            PG8_WAIT_V(8); PG8_WAIT_L(0); PG8_BAR; PG8_MMA(1, 0, At, B0); PG8_MMA(1, 1, At, B1); PG8_BAR; PG8_SCHED;
            PG8_LDB(B0, 1, 0); PG8_LDB(B1, 1, 1); PG8_SCHED; PG8_LDA(At, 1, 0); PG8_STAGE(PG8_SA(0, 1), a2 + hstep, voffA);
            PG8_WAIT_V(8); PG8_WAIT_L(0); PG8_BAR; PG8_MMA(0, 0, At, B0); PG8_MMA(0, 1, At, B1); PG8_BAR; PG8_SCHED;
            PG8_LDA(At, 1, 1); PG8_STAGE(PG8_SB(1, 0), b3, voffB); PG8_STAGE(PG8_SB(1, 1), b3 + hstep, voffB); PG8_STAGE(PG8_SA(1, 0), a3, voffA);
            PG8_WAIT_V(8); PG8_WAIT_L(0); PG8_BAR; PG8_MMA(1, 0, At, B0); PG8_MMA(1, 1, At, B1); PG8_BAR; PG8_SCHED;
            } else {
            PG8_LDB(B0, 0, 0); PG8_SCHED; PG8_LDA(At, 0, 0); PG8_STAGE(PG8_SA(1, 1), a1 + hstep, voffA);
            PG8_WAIT_L(8); PG8_BAR; PG8_WAIT_L(0); PG8_MMA(0, 0, At, B0); PG8_BAR; PG8_SCHED;
            PG8_LDB(B1, 0, 1); PG8_STAGE(PG8_SB(0, 0), b2, voffB);
            PG8_BAR; PG8_WAIT_L(0); PG8_MMA(0, 1, At, B1); PG8_BAR;
            PG8_LDA(At, 0, 1); PG8_STAGE(PG8_SA(0, 0), a2, voffA);
            PG8_BAR; PG8_WAIT_L(0); PG8_MMA(1, 0, At, B0); PG8_BAR; PG8_SCHED;
            PG8_STAGE(PG8_SB(0, 1), b2 + hstep, voffB);
            PG8_WAIT_V(6); PG8_BAR; PG8_MMA(1, 1, At, B1); PG8_BAR;
            PG8_LDB(B0, 1, 0); PG8_SCHED; PG8_LDA(At, 1, 0); PG8_STAGE(PG8_SA(0, 1), a2 + hstep, voffA);
            PG8_WAIT_L(8); PG8_BAR; PG8_WAIT_L(0); PG8_MMA(0, 0, At, B0); PG8_BAR; PG8_SCHED;
            PG8_LDB(B1, 1, 1); PG8_STAGE(PG8_SB(1, 0), b3, voffB);
            PG8_BAR; PG8_WAIT_L(0); PG8_MMA(0, 1, At, B1); PG8_BAR;
            PG8_LDA(At, 1, 1); PG8_STAGE(PG8_SA(1, 0), a3, voffA);
            PG8_BAR; PG8_WAIT_L(0); PG8_MMA(1, 0, At, B0); PG8_BAR; PG8_SCHED;
            PG8_STAGE(PG8_SB(1, 1), b3 + hstep, voffB);
            PG8_WAIT_V(6); PG8_BAR; PG8_MMA(1, 1, At, B1); PG8_BAR;
            }
        }
        if constexpr (ALIGN_EPI) { if (wr == 0) PG8_BAR; }
        if constexpr (!Epi::AFTER_DRAIN) { E(acc, cur, wr, wc, fr, fq); S.done(cur); }
        if (!has_next) break;
#pragma unroll
        for (int a = 0; a < 2; ++a)
#pragma unroll
            for (int b = 0; b < 2; ++b)
#pragma unroll
                for (int m = 0; m < 4; ++m)
#pragma unroll
                    for (int n = 0; n < 2; ++n) acc[a][b][m][n] = (f32x4){0.f, 0.f, 0.f, 0.f};
        cur = nxt; cA = nA; cB = nB; ++ui;
        if constexpr (ALIGN_EPI) { if (wr == 1) PG8_BAR; }
    }
    PG8_WAIT_V(0);
    if constexpr (!ALIGN_EPI) { if (wr == 0) PG8_BAR; }
    PG8_BAR;
    if constexpr (Epi::AFTER_DRAIN) { E.fused(acc, cur, wr, wc, fr, fq, lds, wid, lane); S.done(cur); }
#undef PG8_SA
#undef PG8_SB
#undef PG8_STAGE
#undef PG8_LDA
#undef PG8_LDB
#undef PG8_MMA
#undef PG8_WAIT_V
#undef PG8_WAIT_L
#undef PG8_BAR
#undef PG8_SCHED
}
}
#define LAS __attribute__((address_space(3)))
typedef unsigned short bf16;
typedef short bf16x8 __attribute__((ext_vector_type(8)));
typedef float f32x4 __attribute__((ext_vector_type(4)));
typedef unsigned u32x4 __attribute__((ext_vector_type(4)));
typedef unsigned u32x2 __attribute__((ext_vector_type(2)));
typedef float f32x2 __attribute__((ext_vector_type(2)));
typedef __bf16 bf16x2_t __attribute__((ext_vector_type(2)));

constexpr size_t MiB = 1u << 20;
constexpr size_t WS_CTL = 0, WS_SSQ = 1 * MiB, WS_BON = 3 * MiB, WS_W = 4 * MiB, WS_PB = 58 * MiB, WS_Y = 90 * MiB, WS_XN = 154 * MiB, WS_SCR = 218 * MiB, WS_Z = 266 * MiB, WS_END = 474 * MiB;
constexpr size_t SC_CL = 0, SC_NL = 16 * MiB, SC_MS = 17 * MiB, SC_MIN = SC_MS + 65536, SC_LSUM = 18 * MiB, SC_LHIN = 19 * MiB;
constexpr size_t WO_IN = 0, WO_OUT = WO_IN + (size_t)NZ * DM, WO_1 = WO_OUT + (size_t)DM * DM, WO_2 = WO_1 + (size_t)DFF * DM, WO_G = WO_2 + (size_t)DM * DFF, WO_P = WO_G + (size_t)DM * DM, WO_LAYER = WO_P + (size_t)DM * DPLE;
static_assert(WS_W + 2 * WO_LAYER * 2 <= WS_PB, "weight region");
constexpr int LDS_BYTES = 147456;
constexpr int NWAVES = 8, NTHR = 512;

struct Args { const float* in[33]; float* out; unsigned char* ws; int ph_lo, ph_hi; };

__device__ __forceinline__ float bf2f(unsigned short h) { return __uint_as_float((unsigned)h << 16); }
__device__ __forceinline__ float bflo(unsigned w) { return __uint_as_float(w << 16); }
__device__ __forceinline__ float bfhi(unsigned w) { return __uint_as_float(w & 0xffff0000u); }
__device__ __forceinline__ unsigned pk2(float lo, float hi) { f32x2 v = {lo, hi}; bf16x2_t b = __builtin_convertvector(v, bf16x2_t); return __builtin_bit_cast(unsigned, b); }
__device__ __forceinline__ unsigned short f2bf(float f) { return (unsigned short)(pk2(f, 0.f) & 0xffffu); }
__device__ __forceinline__ float rcpf_(float x) { return __builtin_amdgcn_rcpf(x); }
__device__ __forceinline__ float sigmoidf_(float x) { return rcpf_(1.0f + __expf(-x)); }
__device__ __forceinline__ float softplusf_(float x) { return fmaxf(x, 0.f) + __logf(1.0f + __expf(-fabsf(x))); }
__device__ __forceinline__ float tanhf_(float x) { return 1.0f - 2.0f * rcpf_(1.0f + __expf(2.0f * x)); }
__device__ __forceinline__ float wave_sum(float v) {
#pragma unroll
    for (int o = 1; o < 64; o <<= 1) v += __shfl_xor(v, o);
    return v;
}
template <int CTRL> __device__ __forceinline__ float dppf(float x) { return __builtin_bit_cast(float, __builtin_amdgcn_update_dpp(0, __builtin_bit_cast(int, x), CTRL, 0xf, 0xf, true)); }
__device__ __forceinline__ float row16_sum(float x) {
    x += dppf<0x128>(x); x += dppf<0x124>(x); x += dppf<0x122>(x); x += dppf<0x121>(x); return x;
}
#define LDS_WAIT() asm volatile("s_waitcnt lgkmcnt(0)" ::: "memory")

typedef const float* const __attribute__((address_space(4)))* KTab;
struct Frame {
    LAS unsigned char* lds; unsigned char* ws; KTab in; float* out;
    int tid, lane, wave, bid, nblk;
    bf16 *XN, *Y, *Z, *HID, *PB; float *SSQ, *BON;
};
__device__ __forceinline__ bf16* wlayer(const Frame& F, int l) { return (bf16*)(F.ws + WS_W) + (size_t)l * WO_LAYER; }

__device__ __forceinline__ void transpose_item(const float* W, int K, int N, int Npad, bf16* WT, LAS float* scr, int item, int lane) {
    const int nblk = Npad / 32, kb = item / nblk, nb = item % nblk, k0 = 64 * kb, n0 = 32 * nb;
    const int n = n0 + (lane & 31);
#pragma unroll 8
    for (int i = 0; i < 32; ++i) { const int kk = 2 * i + (lane >> 5); scr[kk * 33 + (lane & 31)] = (n < N) ? W[(size_t)(k0 + kk) * N + n] : 0.f; }
    LDS_WAIT();
    const int c = lane & 7;
#pragma unroll
    for (int j = 0; j < 4; ++j) { const int nn = (lane >> 3) + 8 * j; const LAS float* s = scr + (8 * c) * 33 + nn;
        u32x4 o; o.x = pk2(s[0 * 33], s[1 * 33]); o.y = pk2(s[2 * 33], s[3 * 33]); o.z = pk2(s[4 * 33], s[5 * 33]); o.w = pk2(s[6 * 33], s[7 * 33]);
        *(u32x4*)(WT + (size_t)(n0 + nn) * K + k0 + 8 * c) = o; }
    LDS_WAIT();
}
__device__ __forceinline__ void norm_row(const float* xrow, const float* g, bf16* orow, int lane) {
    const f32x4* xp = (const f32x4*)xrow + 2 * lane; const f32x4* gp = (const f32x4*)g + 2 * lane;
    f32x4 v[4]; float s = 0.f;
#pragma unroll
    for (int j = 0; j < 2; ++j) { v[2 * j] = xp[128 * j]; v[2 * j + 1] = xp[128 * j + 1]; }
#pragma unroll
    for (int j = 0; j < 4; ++j) s += (v[j].x * v[j].x + v[j].y * v[j].y) + (v[j].z * v[j].z + v[j].w * v[j].w);
    const float r = rsqrtf(wave_sum(s) * (1.f / DM) + EPS);
#pragma unroll
    for (int j = 0; j < 2; ++j) { const f32x4 ga = gp[128 * j], gb = gp[128 * j + 1]; const f32x4 a = v[2 * j] * r * ga, b = v[2 * j + 1] * r * gb;
        u32x4 o; o.x = pk2(a.x, a.y); o.y = pk2(a.z, a.w); o.z = pk2(b.x, b.y); o.w = pk2(b.z, b.w); *((u32x4*)orow + lane + 64 * j) = o; }
}
__device__ __forceinline__ void phase_prologue(Frame& F) {
    LAS float* scr = (LAS float*)(F.lds + F.wave * 16384);
    const int gw = F.bid * NWAVES + F.wave, NGW = F.nblk * NWAVES;
    constexpr int I_IN = 16 * (NZ / 32), I_OUT = 16 * 32, I_1 = 16 * 128, I_2 = 64 * 32, I_G = 16 * 32, I_P = 4 * 32, I_L = I_IN + I_OUT + I_1 + I_2 + I_G + I_P;
    for (int it = gw; it < 2 * I_L; it += NGW) {
        const int l = it / I_L; int r = it % I_L; bf16* wl = wlayer(F, l);
        if (r < I_IN) { transpose_item(F.in[7] + (size_t)l * DM * DIN, DM, DIN, NZ, wl + WO_IN, scr, r, F.lane); continue; } r -= I_IN;
        if (r < I_OUT) { transpose_item(F.in[8] + (size_t)l * DM * DM, DM, DM, DM, wl + WO_OUT, scr, r, F.lane); continue; } r -= I_OUT;
        if (r < I_1) { transpose_item(F.in[29] + (size_t)l * DM * DFF, DM, DFF, DFF, wl + WO_1, scr, r, F.lane); continue; } r -= I_1;
        if (r < I_2) { transpose_item(F.in[30] + (size_t)l * DFF * DM, DFF, DM, DM, wl + WO_2, scr, r, F.lane); continue; } r -= I_2;
        if (r < I_G) { transpose_item(F.in[32] + (size_t)l * DM * DM, DM, DM, DM, wl + WO_G, scr, r, F.lane); continue; } r -= I_G;
        transpose_item(F.in[31] + (size_t)l * DPLE * DM, DPLE, DM, DM, wl + WO_P, scr, r, F.lane);
    }
    { const size_t ngrp = (size_t)DEPTH * MTOK * DPLE / 8; const f32x4* p4 = (const f32x4*)F.in[1]; u32x4* o = (u32x4*)F.PB;
      for (size_t gi = (size_t)F.bid * NTHR + F.tid; gi < ngrp; gi += (size_t)F.nblk * NTHR) { const f32x4 a = p4[2 * gi], b = p4[2 * gi + 1];
          u32x4 w; w.x = pk2(a.x, a.y); w.y = pk2(a.z, a.w); w.z = pk2(b.x, b.y); w.w = pk2(b.z, b.w); o[gi] = w; } }
    for (int m = gw; m < MTOK; m += NGW) norm_row(F.in[0] + (size_t)m * DM, F.in[2], F.XN + (size_t)m * DM, F.lane);
}

template <bool NORM> __device__ __forceinline__ void phase_rowpass(Frame& F, const float* xin, const bf16* T, const float* gpost, float* xout, bf16* XNo, const float* gpre) {
    const int gw = F.bid * NWAVES + F.wave, NGW = F.nblk * NWAVES, lane = F.lane;
    for (int row = gw; row < MTOK; row += NGW) {
        const u32x4* tp = (const u32x4*)(T + (size_t)row * DM) + lane; const f32x4* xp = (const f32x4*)(xin + (size_t)row * DM) + 2 * lane;
        const f32x4* gp = (const f32x4*)gpost + 2 * lane; f32x4* xo = (f32x4*)(xout + (size_t)row * DM) + 2 * lane;
        float sp = F.SSQ[(size_t)row * 16 + (lane & 15)]; sp = row16_sum(sp);
        const float rt = rsqrtf(sp * (1.f / DM) + EPS);
        f32x4 y[4]; float s2 = 0.f;
#pragma unroll
        for (int j = 0; j < 2; ++j) { const u32x4 t = tp[64 * j]; const f32x4 xa = xp[128 * j], xb = xp[128 * j + 1], ga = gp[128 * j], gb = gp[128 * j + 1];
            f32x4 ta = {bflo(t.x), bfhi(t.x), bflo(t.y), bfhi(t.y)}, tb = {bflo(t.z), bfhi(t.z), bflo(t.w), bfhi(t.w)};
            y[2 * j] = xa + ta * rt * ga; y[2 * j + 1] = xb + tb * rt * gb; xo[128 * j] = y[2 * j]; xo[128 * j + 1] = y[2 * j + 1]; }
        float r = 1.f;
        if (NORM) {
#pragma unroll
            for (int j = 0; j < 4; ++j) s2 += (y[j].x * y[j].x + y[j].y * y[j].y) + (y[j].z * y[j].z + y[j].w * y[j].w);
            r = rsqrtf(wave_sum(s2) * (1.f / DM) + EPS); }
        if (XNo) {
            const f32x4* gq = (const f32x4*)gpre + 2 * lane;
#pragma unroll
            for (int j = 0; j < 2; ++j) { f32x4 a = y[2 * j], b = y[2 * j + 1];
                if (NORM) { a = a * r * gq[128 * j]; b = b * r * gq[128 * j + 1]; }
                u32x4 o; o.x = pk2(a.x, a.y); o.y = pk2(a.z, a.w); o.z = pk2(b.x, b.y); o.w = pk2(b.z, b.w); *((u32x4*)(XNo + (size_t)row * DM) + lane + 64 * j) = o; } }
    }
}

template <int MODE> __device__ __forceinline__ void phase_gemm(Frame& F, const bf16* A, const bf16* Bt, int N, int K, bf16* O, int ldc) {
    pg8::Gemm g{A, Bt, MTOK, N, K}; pg8::StaticOrder S; S.init(MTOK, N, F.nblk, F.bid);
    pg8::EpiOut<MODE> E{O, ldc, F.SSQ};
    pg8::gemm_phase<pg8::EpiOut<MODE>, pg8::StaticOrder, true, true>(F.lds, g, S, E, F.tid);
}

__device__ __forceinline__ void rw_rec_unit(Frame& F, int l, int unit) {
    const int b = unit >> 4, h = (unit >> 1) & 7, half = unit & 1, tid = F.tid, lane = F.lane, wave = F.wave;
    LAS float* Wd = (LAS float*)F.lds; LAS float* NKK = Wd + 2048; LAS float* KKA = Wd + 4096; LAS float* KP = Wd + 6144; LAS float* RR = Wd + 8192;
    LAS float* VV = Wd + 10240; LAS float* OUT = Wd + 11264; LAS float* LW = Wd + 12288; LAS float* LA = Wd + 13312;
    const int c = tid & 63, hc = h * 64 + c;
    const float* mu = F.in[18] + (size_t)l * 1696;
    const float mu_r = mu[hc], mu_k = mu[512 + hc], mu_v = mu[1024 + hc];
    const float w0c = F.in[19][l * 512 + hc], a0c = F.in[21][l * 512 + hc], kkc = F.in[24][l * 512 + hc], kac = F.in[25][l * 512 + hc], rkc = F.in[26][l * 512 + hc];
    float w2c[32], a2c[32];
#pragma unroll
    for (int j = 0; j < 32; ++j) { w2c[j] = F.in[20][((size_t)l * 32 + j) * 512 + hc]; a2c[j] = F.in[22][((size_t)l * 32 + j) * 512 + hc]; }
    const bf16* Zb = F.Z + (size_t)b * SEQ * NZ;
    float S0 = 0.f, S1 = 0.f, S2 = 0.f, S3 = 0.f;
    const int ks = (lane & 15) * 4, vr = wave * 4 + (lane >> 4);
    for (int t0 = 0; t0 < SEQ; t0 += 32) {
        {
            const int tt = tid >> 4, j4 = (tid & 15) * 4, t = t0 + tt;
            const bf16* zr = Zb + (size_t)t * NZ + ZC_WD + j4; const u32x2 cu = *(const u32x2*)zr; u32x2 pv = {0u, 0u}; if (t > 0) pv = *(const u32x2*)(zr - NZ);
            const f32x4 m4 = *(const f32x4*)(mu + 1536 + j4);
            const float c0 = bflo(cu.x), c1 = bfhi(cu.x), c2 = bflo(cu.y), c3 = bfhi(cu.y);
            float v0 = c0 + (bflo(pv.x) - c0) * m4.x, v1 = c1 + (bfhi(pv.x) - c1) * m4.y, v2 = c2 + (bflo(pv.y) - c2) * m4.z, v3 = c3 + (bfhi(pv.y) - c3) * m4.w;
            if (j4 < 32) { *(LAS f32x4*)(LW + tt * 32 + j4) = (f32x4){tanhf(v0), tanhf(v1), tanhf(v2), tanhf(v3)}; }
            else { *(LAS f32x4*)(LA + tt * 32 + j4 - 32) = (f32x4){v0, v1, v2, v3}; }
        }
        __syncthreads();
#pragma unroll 1
        for (int i = 0; i < 4; ++i) {
            const int tt = wave + 8 * i, t = t0 + tt; const bf16* zr = Zb + (size_t)t * NZ;
            const float zr_r = bf2f(zr[ZC_RR + hc]), zr_k = bf2f(zr[ZC_RK + hc]), zr_v = bf2f(zr[ZC_RV + hc]);
            float pr = 0.f, pk = 0.f, pvv = 0.f; if (t > 0) { pr = bf2f(zr[ZC_RR + hc - NZ]); pk = bf2f(zr[ZC_RK + hc - NZ]); pvv = bf2f(zr[ZC_RV + hc - NZ]); }
            const float r = zr_r + (pr - zr_r) * mu_r, k = zr_k + (pk - zr_k) * mu_k, v = zr_v + (pvv - zr_v) * mu_v;
            float lw = w0c, la = a0c;
#pragma unroll
            for (int j4 = 0; j4 < 8; ++j4) { const f32x4 x = *(LAS f32x4*)(LW + tt * 32 + 4 * j4), y = *(LAS f32x4*)(LA + tt * 32 + 4 * j4);
                lw += x.x * w2c[4 * j4] + x.y * w2c[4 * j4 + 1] + x.z * w2c[4 * j4 + 2] + x.w * w2c[4 * j4 + 3];
                la += y.x * a2c[4 * j4] + y.y * a2c[4 * j4 + 1] + y.z * a2c[4 * j4 + 2] + y.w * a2c[4 * j4 + 3]; }
            const float wlog = -softplusf_(-lw) - 0.5f, decay = __expf(-__expf(wlog)), al = sigmoidf_(la);
            const float kkv = k * kkc, nrm = sqrtf(wave_sum(kkv * kkv)), kk = kkv / fmaxf(nrm, 1e-12f);
            const float kp = k * (1.f + (al - 1.f) * kac);
            const float bon = wave_sum(r * kp * rkc);
            if (half == 0 && c == 0) F.BON[((size_t)b * SEQ + t) * 8 + h] = bon;
            Wd[tt * 64 + c] = decay; NKK[tt * 64 + c] = -kk; KKA[tt * 64 + c] = kk * al; KP[tt * 64 + c] = kp; RR[tt * 64 + c] = r;
            if ((c >> 5) == half) VV[tt * 32 + (c & 31)] = v;
        }
        __syncthreads();
#pragma unroll 4
        for (int tt = 0; tt < 32; ++tt) {
            const f32x4 w4 = *(LAS f32x4*)(Wd + tt * 64 + ks), n4 = *(LAS f32x4*)(NKK + tt * 64 + ks), a4 = *(LAS f32x4*)(KKA + tt * 64 + ks), k4 = *(LAS f32x4*)(KP + tt * 64 + ks), r4 = *(LAS f32x4*)(RR + tt * 64 + ks);
            const float vv = VV[tt * 32 + vr];
            float sa = (S0 * n4.x + S1 * n4.y) + (S2 * n4.z + S3 * n4.w); sa = row16_sum(sa);
            S0 = S0 * w4.x + sa * a4.x + vv * k4.x; S1 = S1 * w4.y + sa * a4.y + vv * k4.y; S2 = S2 * w4.z + sa * a4.z + vv * k4.z; S3 = S3 * w4.w + sa * a4.w + vv * k4.w;
            float o = (S0 * r4.x + S1 * r4.y) + (S2 * r4.z + S3 * r4.w); o = row16_sum(o);
            if ((lane & 15) == 0) OUT[tt * 32 + vr] = o;
        }
        __syncthreads();
        { const int tt = tid >> 4, pr = tid & 15; const f32x2 o2 = *(LAS f32x2*)(OUT + tt * 32 + 2 * pr);
          *(unsigned*)(F.Y + ((size_t)b * SEQ + t0 + tt) * DM + 512 + h * 64 + half * 32 + 2 * pr) = pk2(o2.x, o2.y); }
    }
    __syncthreads();
}
__device__ __forceinline__ void phase_rw_epi(Frame& F, int l) {
    const int tid = F.tid, c = tid, h = F.wave;
    LAS float* SG = (LAS float*)F.lds;
    const float* mu = F.in[18] + (size_t)l * 1696; const float mu_v = mu[1024 + c];
    const float lnw = F.in[27][l * 512 + c], lnb = F.in[28][l * 512 + c];
    float g2c[96];
#pragma unroll
    for (int j = 0; j < 96; ++j) g2c[j] = F.in[23][((size_t)l * 96 + j) * 512 + c];
    for (int u = F.bid; u < MTOK / 32; u += F.nblk) {
        const int tok0 = u * 32;
        __syncthreads();
#pragma unroll
        for (int i = 0; i < 6; ++i) { const int e = tid + 512 * i, tt = e / 96, j = e % 96, tok = tok0 + tt; const bf16* zr = F.Z + (size_t)tok * NZ + ZC_GD + j;
            const float cu = bf2f(zr[0]); float pv = 0.f; if ((tok & (SEQ - 1)) != 0) pv = bf2f(zr[-NZ]);
            SG[e] = sigmoidf_(cu + (pv - cu) * mu[1600 + j]); }
        __syncthreads();
#pragma unroll 1
        for (int tt = 0; tt < 32; ++tt) { const int tok = tok0 + tt; bf16* yp = F.Y + (size_t)tok * DM + 512 + c;
            const float o = bf2f(F.XN[(size_t)tok * 512 + c]); const float mean = wave_sum(o) * (1.f / 64.f), d = o - mean, var = wave_sum(d * d) * (1.f / 64.f);
            const float on = d * rsqrtf(var + 64e-5f) * lnw + lnb;
            const bf16* zr = F.Z + (size_t)tok * NZ + ZC_RV + c; const float cu = bf2f(zr[0]); float pv = 0.f; if ((tok & (SEQ - 1)) != 0) pv = bf2f(zr[-NZ]);
            const float v = cu + (pv - cu) * mu_v, bon = F.BON[(size_t)tok * 8 + h];
            float g = 0.f;
#pragma unroll
            for (int j4 = 0; j4 < 24; ++j4) { const f32x4 s = *(LAS f32x4*)(SG + tt * 96 + 4 * j4); g += s.x * g2c[4 * j4] + s.y * g2c[4 * j4 + 1] + s.z * g2c[4 * j4 + 2] + s.w * g2c[4 * j4 + 3]; }
            *yp = f2bf((on + bon * v) * g); }
    }
}

struct RwOps { f32x4 w, n, a, k, r; float v; };
__device__ __forceinline__ float rw_step(f32x2& Sa, f32x2& Sb, const RwOps& p) {
    const f32x2 na = {p.n.x, p.n.y}, nb = {p.n.z, p.n.w}, wa = {p.w.x, p.w.y}, wb = {p.w.z, p.w.w}, aa = {p.a.x, p.a.y}, ab = {p.a.z, p.a.w}, ka = {p.k.x, p.k.y}, kb = {p.k.z, p.k.w}, ra = {p.r.x, p.r.y}, rb = {p.r.z, p.r.w};
    const f32x2 ps = Sa * na + Sb * nb; float sa = row16_sum(ps.x + ps.y);
    const f32x2 ta = Sa * wa + ka * p.v, tb = Sb * wb + kb * p.v;
    Sa = ta + aa * sa; Sb = tb + ab * sa;
    const f32x2 po = Sa * ra + Sb * rb; return row16_sum(po.x + po.y);
}
struct RwRaw { u32x2 rc[2], kc[2], vc[2], rp[2], kp[2], vp[2], lc[2], lp[2]; };
__device__ __forceinline__ f32x4 bf4(u32x2 w) { return (f32x4){bflo(w.x), bfhi(w.x), bflo(w.y), bfhi(w.y)}; }
__device__ __forceinline__ void rw_load_raw(RwRaw& R, const bf16* Zb, int t0, int pw, int rr, int fr, int h) {
#pragma unroll
    for (int i = 0; i < 2; ++i) { const int t = t0 + 8 * pw + 4 * i + rr; const bf16* zr = Zb + (size_t)t * NZ; const int co = h * 64 + 4 * fr;
        R.rc[i] = *(const u32x2*)(zr + ZC_RR + co); R.kc[i] = *(const u32x2*)(zr + ZC_RK + co); R.vc[i] = *(const u32x2*)(zr + ZC_RV + co); R.lc[i] = *(const u32x2*)(zr + ZC_WD + 4 * fr);
        const bf16* zp = (t > 0) ? zr - NZ : zr; const unsigned keep = (t > 0) ? 0xffffffffu : 0u;
        R.rp[i] = *(const u32x2*)(zp + ZC_RR + co); R.kp[i] = *(const u32x2*)(zp + ZC_RK + co); R.vp[i] = *(const u32x2*)(zp + ZC_RV + co); R.lp[i] = *(const u32x2*)(zp + ZC_WD + 4 * fr);
        R.rp[i].x &= keep; R.rp[i].y &= keep; R.kp[i].x &= keep; R.kp[i].y &= keep; R.vp[i].x &= keep; R.vp[i].y &= keep; R.lp[i].x &= keep; R.lp[i].y &= keep; }
}
__device__ __forceinline__ void rw_rec_unit2(Frame& F, int l, int unit) {
    const int xcd = unit & 7, idx = unit >> 3, p = xcd * 8 + (idx >> 2), q = idx & 3, b = p >> 3, h = p & 7;
    const int tid = F.tid, lane = F.lane, wave = F.wave, rr = lane >> 4, fr = lane & 15;
    LAS float* BUF = (LAS float*)F.lds;
    constexpr int BUFF = 5 * 2048 + 512;
    LAS float* OUT = BUF + 2 * BUFF;
    LAS bf16* W2T = (LAS bf16*)(OUT + 1024); LAS bf16* A2T = W2T + 64 * 40;
    LAS bf16* ATs = A2T + 64 * 40;
    const bf16* Zb = F.Z + (size_t)b * SEQ * NZ;
    for (int e = tid; e < 2048; e += NTHR) { const int j = e >> 6, c = e & 63; W2T[c * 40 + j] = f2bf(F.in[20][((size_t)l * 32 + j) * 512 + h * 64 + c]); A2T[c * 40 + j] = f2bf(F.in[22][((size_t)l * 32 + j) * 512 + h * 64 + c]); }
    __syncthreads();
    if (wave < 4) {
        f32x2 Sa = {0.f, 0.f}, Sb = {0.f, 0.f}; const int ks = fr * 4, vr = wave * 4 + rr;
        __syncthreads();
        for (int c = 0; c < SEQ / 32; ++c) {
            LAS float* B0 = BUF + (c & 1) * BUFF + ks; LAS float* V0 = BUF + (c & 1) * BUFF + 10240 + vr; LAS float* O0 = OUT + (c & 1) * 512 + fr * 16 + vr;
            RwOps ga[4], gb[4]; float osave = 0.f;
#define RW_LDG(G, T0) _Pragma("unroll") for (int j_ = 0; j_ < 4; ++j_) { G[j_].w = *(LAS f32x4*)(B0 + ((T0) + j_) * 64); G[j_].n = *(LAS f32x4*)(B0 + 2048 + ((T0) + j_) * 64); G[j_].a = *(LAS f32x4*)(B0 + 4096 + ((T0) + j_) * 64); \
                G[j_].k = *(LAS f32x4*)(B0 + 6144 + ((T0) + j_) * 64); G[j_].r = *(LAS f32x4*)(B0 + 8192 + ((T0) + j_) * 64); G[j_].v = V0[((T0) + j_) * 16]; }
#define RW_ST4(G, T0) _Pragma("unroll") for (int j_ = 0; j_ < 4; ++j_) { const float o_ = rw_step(Sa, Sb, G[j_]); osave = (fr == (((T0) + j_) & 15)) ? o_ : osave; }
            RW_LDG(ga, 0);
#pragma unroll
            for (int g = 0; g < 8; g += 2) {
                RW_LDG(gb, 4 * g + 4);
                RW_ST4(ga, 4 * g);
                if (g + 2 < 8) { RW_LDG(ga, 4 * g + 8); }
                RW_ST4(gb, 4 * g + 4);
                if (g == 2) O0[0] = osave;
            }
            O0[256] = osave;
#undef RW_LDG
#undef RW_ST4
            __syncthreads();
        }
    } else {
        const int pw = wave - 4, pt = tid - 256;
        LAS bf16* AT = ATs + pw * 3200; LAS float* LO = (LAS float*)(AT + 16 * 72);
        const float* mu = F.in[18] + (size_t)l * 1696; const int co = h * 64 + 4 * fr;
        const f32x4 mu_r = *(const f32x4*)(mu + co), mu_k = *(const f32x4*)(mu + 512 + co), mu_v = *(const f32x4*)(mu + 1024 + co), mu_l = *(const f32x4*)(mu + 1536 + 4 * fr);
        const f32x4 w0 = *(const f32x4*)(F.in[19] + l * 512 + co), a0 = *(const f32x4*)(F.in[21] + l * 512 + co), k_k = *(const f32x4*)(F.in[24] + l * 512 + co), k_a = *(const f32x4*)(F.in[25] + l * 512 + co), r_k = *(const f32x4*)(F.in[26] + l * 512 + co);
        RwRaw R; rw_load_raw(R, Zb, 0, pw, rr, fr, h);
        for (int c = -1; c < SEQ / 32; ++c) {
            if (c > 0) {
                const int tt = pt >> 3, pr = pt & 7; const f32x2 o2 = *(LAS f32x2*)(OUT + ((c - 1) & 1) * 512 + tt * 16 + 2 * pr);
                *(unsigned*)(F.XN + ((size_t)b * SEQ + (c - 1) * 32 + tt) * 512 + h * 64 + q * 16 + 2 * pr) = pk2(o2.x, o2.y); }
            if (c + 1 < SEQ / 32) {
                const int t0 = (c + 1) * 32; LAS float* B1 = BUF + ((c + 1) & 1) * BUFF;
#pragma unroll
                for (int i = 0; i < 2; ++i) { const f32x4 cu = bf4(R.lc[i]), pv = bf4(R.lp[i]); f32x4 x = cu + (pv - cu) * mu_l;
                    if (fr < 8) { x.x = tanhf_(x.x); x.y = tanhf_(x.y); x.z = tanhf_(x.z); x.w = tanhf_(x.w); }
                    u32x2 o; o.x = pk2(x.x, x.y); o.y = pk2(x.z, x.w); *(LAS u32x2*)(AT + (4 * i + rr) * 72 + 4 * fr) = o; }
                LDS_WAIT();
                { const bf16x8 aW = *(LAS bf16x8*)(AT + fr * 72 + 8 * rr), aA = *(LAS bf16x8*)(AT + fr * 72 + 32 + 8 * rr);
#pragma unroll
                  for (int ct = 0; ct < 4; ++ct) { const bf16x8 bW = *(LAS bf16x8*)(W2T + (16 * ct + fr) * 40 + 8 * rr), bA = *(LAS bf16x8*)(A2T + (16 * ct + fr) * 40 + 8 * rr);
                      const f32x4 z4 = {0.f, 0.f, 0.f, 0.f}; const f32x4 cw = __builtin_amdgcn_mfma_f32_16x16x32_bf16(aW, bW, z4, 0, 0, 0), ca = __builtin_amdgcn_mfma_f32_16x16x32_bf16(aA, bA, z4, 0, 0, 0);
                      if (rr < 2) {
#pragma unroll
                          for (int r = 0; r < 4; ++r) { LO[(4 * rr + r) * 64 + 16 * ct + fr] = cw[r]; LO[512 + (4 * rr + r) * 64 + 16 * ct + fr] = ca[r]; } } } }
                LDS_WAIT();
#pragma unroll
                for (int i = 0; i < 2; ++i) { const int row = 4 * i + rr, tt = 8 * pw + row, t = t0 + tt;
                    const f32x4 lw = *(LAS f32x4*)(LO + row * 64 + 4 * fr) + w0, la = *(LAS f32x4*)(LO + 512 + row * 64 + 4 * fr) + a0;
                    const f32x4 rc = bf4(R.rc[i]), kc = bf4(R.kc[i]), vc = bf4(R.vc[i]);
                    const f32x4 r = rc + (bf4(R.rp[i]) - rc) * mu_r, k = kc + (bf4(R.kp[i]) - kc) * mu_k, v = vc + (bf4(R.vp[i]) - vc) * mu_v;
                    f32x4 dec, al, kkv, kp; float s2 = 0.f, bs = 0.f;
#pragma unroll
                    for (int e = 0; e < 4; ++e) { dec[e] = __expf(-0.6065306597126334f * sigmoidf_(lw[e]));     al[e] = sigmoidf_(la[e]); kkv[e] = k[e] * k_k[e]; s2 += kkv[e] * kkv[e];
                        kp[e] = k[e] * (1.f + (al[e] - 1.f) * k_a[e]); bs += r[e] * kp[e] * r_k[e]; }
                    s2 = row16_sum(s2); bs = row16_sum(bs);
                    const float inv = fminf(rsqrtf(s2), 1e12f); const f32x4 kk = kkv * inv;
                    *(LAS f32x4*)(B1 + tt * 64 + 4 * fr) = dec; *(LAS f32x4*)(B1 + 2048 + tt * 64 + 4 * fr) = -kk; *(LAS f32x4*)(B1 + 4096 + tt * 64 + 4 * fr) = kk * al;
                    *(LAS f32x4*)(B1 + 6144 + tt * 64 + 4 * fr) = kp; *(LAS f32x4*)(B1 + 8192 + tt * 64 + 4 * fr) = r;
                    if ((fr >> 2) == q) *(LAS f32x4*)(B1 + 10240 + tt * 16 + 4 * (fr & 3)) = v;
                    if (q == 0 && fr == 0) F.BON[((size_t)b * SEQ + t) * 8 + h] = bs; }
                if (c + 2 < SEQ / 32) rw_load_raw(R, Zb, (c + 2) * 32, pw, rr, fr, h);
            }
            __syncthreads();
        }
        { const int c = SEQ / 32; const int tt = pt >> 3, pr = pt & 7; const f32x2 o2 = *(LAS f32x2*)(OUT + ((c - 1) & 1) * 512 + tt * 16 + 2 * pr);
          *(unsigned*)(F.XN + ((size_t)b * SEQ + (c - 1) * 32 + tt) * 512 + h * 64 + q * 16 + 2 * pr) = pk2(o2.x, o2.y); }
    }
    __syncthreads();
}
__device__ __forceinline__ void phase_rw_epi2(Frame& F, int l) {
    const int tid = F.tid, lane = F.lane, h = F.wave, fr = lane & 15, fq = lane >> 4, cc0 = h * 64 + 4 * fr;
    LAS bf16* SG = (LAS bf16*)F.lds;
    const float* mu = F.in[18] + (size_t)l * 1696;
    const f32x4 mu_v = *(const f32x4*)(mu + 1024 + cc0), lnw = *(const f32x4*)(F.in[27] + l * 512 + cc0), lnb = *(const f32x4*)(F.in[28] + l * 512 + cc0);
    bf16x8 bg[4][3];
#pragma unroll
    for (int ct = 0; ct < 4; ++ct)
#pragma unroll
        for (int ks = 0; ks < 3; ++ks)
#pragma unroll
            for (int e = 0; e < 8; ++e) bg[ct][ks][e] = (short)f2bf(F.in[23][((size_t)l * 96 + 32 * ks + 8 * fq + e) * 512 + cc0 + ct]);
    for (int u = F.bid; u < MTOK / 64; u += F.nblk) {
        const int tok0 = u * 64;
        __syncthreads();
#pragma unroll
        for (int i = 0; i < 3; ++i) { const int g = tid + NTHR * i, tt = g / 24, j4 = (g % 24) * 4, tok = tok0 + tt; const bf16* zr = F.Z + (size_t)tok * NZ + ZC_GD + j4;
            const bool first = (tok & (SEQ - 1)) == 0; const u32x2 cu = *(const u32x2*)zr; u32x2 pv = *(const u32x2*)(first ? zr : zr - NZ); if (first) { pv.x = 0u; pv.y = 0u; }
            const f32x4 c4 = bf4(cu), m4 = *(const f32x4*)(mu + 1600 + j4); const f32x4 x = c4 + (bf4(pv) - c4) * m4;
            u32x2 o; o.x = pk2(sigmoidf_(x.x), sigmoidf_(x.y)); o.y = pk2(sigmoidf_(x.z), sigmoidf_(x.w)); *(LAS u32x2*)(SG + tt * 104 + j4) = o; }
        __syncthreads();
#pragma unroll 1
        for (int rt = 0; rt < 4; ++rt) {
            f32x4 acc[4];
#pragma unroll
            for (int ct = 0; ct < 4; ++ct) acc[ct] = (f32x4){0.f, 0.f, 0.f, 0.f};
#pragma unroll
            for (int ks = 0; ks < 3; ++ks) { const bf16x8 a = *(LAS bf16x8*)(SG + (16 * rt + fr) * 104 + 32 * ks + 8 * fq);
#pragma unroll
                for (int ct = 0; ct < 4; ++ct) acc[ct] = __builtin_amdgcn_mfma_f32_16x16x32_bf16(a, bg[ct][ks], acc[ct], 0, 0, 0); }
#pragma unroll
            for (int r = 0; r < 4; ++r) { const int tok = tok0 + 16 * rt + 4 * fq + r; const bool first = (tok & (SEQ - 1)) == 0;
                const f32x4 o4 = bf4(*(const u32x2*)(F.XN + (size_t)tok * 512 + cc0));
                const bf16* zr = F.Z + (size_t)tok * NZ + ZC_RV + cc0; const f32x4 vc = bf4(*(const u32x2*)zr); u32x2 pv = *(const u32x2*)(first ? zr : zr - NZ); if (first) { pv.x = 0u; pv.y = 0u; }
                const f32x4 v = vc + (bf4(pv) - vc) * mu_v; const float bon = F.BON[(size_t)tok * 8 + h];
                const float mean = row16_sum((o4.x + o4.y) + (o4.z + o4.w)) * (1.f / 64.f); const f32x4 d = o4 - mean;
                const float var = row16_sum((d.x * d.x + d.y * d.y) + (d.z * d.z + d.w * d.w)) * (1.f / 64.f); const float rs = rsqrtf(var + 64e-5f);
                const f32x4 g4 = {acc[0][r], acc[1][r], acc[2][r], acc[3][r]};
                const f32x4 y = (d * rs * lnw + lnb + v * bon) * g4;
                u32x2 o; o.x = pk2(y.x, y.y); o.y = pk2(y.z, y.w); *(u32x2*)(F.Y + (size_t)tok * DM + 512 + cc0) = o; }
        }
    }
}
__device__ __forceinline__ float wave_scan_add(float v, int lane) {
#pragma unroll
    for (int o = 1; o < 64; o <<= 1) { const float t = __shfl_up(v, o); if (lane >= o) v += t; }
    return v;
}
__device__ __forceinline__ float wave_scan_max(float v, int lane) {
#pragma unroll
    for (int o = 1; o < 64; o <<= 1) { const float t = __shfl_up(v, o); if (lane >= o) v = fmaxf(v, t); }
    return v;
}
struct MlScr { bf16* CL; float* NL; float* MS; float* MIN; };
__device__ __forceinline__ MlScr ml_scr(const Frame& F) { MlScr s; unsigned char* b = F.ws + WS_SCR; s.CL = (bf16*)(b + SC_CL); s.NL = (float*)(b + SC_NL); s.MS = (float*)(b + SC_MS); s.MIN = (float*)(b + SC_MIN); return s; }

__device__ __forceinline__ void phase_mlstm_a(Frame& F, int l) {
    const MlScr sc = ml_scr(F);
    const int tid = F.tid, lane = F.lane, hw = tid >> 8, ht = tid & 255, w4 = F.wave & 3, fr = lane & 15, fq = lane >> 4;
    constexpr int LP = 72;
    LAS bf16* VT = (LAS bf16*)(F.lds + hw * 32768); LAS bf16* WKT = VT + 64 * LP; LAS float* WL = (LAS float*)(WKT + 64 * LP);
    for (int u2 = F.bid; u2 < 1024; u2 += F.nblk) {
        const int unit = u2 * 2 + hw, c = unit & 63, h = (unit >> 6) & 3, b = unit >> 8, t0 = c * 64;
        const bf16* Zb = F.Z + (size_t)b * SEQ * NZ;
        const float bias_i = F.in[9][l * 8 + h], bias_f = F.in[9][l * 8 + 4 + h];
        const int row = ht >> 2, c16 = (ht & 3) * 16; const bf16* zr = Zb + (size_t)(t0 + row) * NZ + h * 64 + c16;
        const u32x4 k8a = *(const u32x4*)(zr + ZC_K), k8b = *(const u32x4*)(zr + ZC_K + 8), v8a = *(const u32x4*)(zr + ZC_V), v8b = *(const u32x4*)(zr + ZC_V + 8);
        if (w4 == 0) {
            const bf16* zg = Zb + (size_t)(t0 + lane) * NZ; const float fp = bf2f(zg[ZC_F + h]) + bias_f, ig = bf2f(zg[ZC_I + h]) + bias_i;
            const float lf = -softplusf_(-fp); const float Fc = wave_scan_add(lf, lane); const float g = ig - Fc; const float pm = wave_scan_max(g, lane);
            const float Ftot = __shfl(Fc, 63), gmax = __shfl(pm, 63);
            WL[lane] = __expf(g - gmax);
            if (lane == 0) { sc.MS[unit * 2] = Ftot + gmax; sc.MS[unit * 2 + 1] = Ftot; }
        }
        __syncthreads();
        { const float wl = WL[row]; const unsigned kw[8] = {k8a.x, k8a.y, k8a.z, k8a.w, k8b.x, k8b.y, k8b.z, k8b.w}, vw[8] = {v8a.x, v8a.y, v8a.z, v8a.w, v8b.x, v8b.y, v8b.z, v8b.w};
#pragma unroll
          for (int e = 0; e < 8; ++e) { WKT[(c16 + 2 * e) * LP + row] = f2bf(bflo(kw[e]) * wl); WKT[(c16 + 2 * e + 1) * LP + row] = f2bf(bfhi(kw[e]) * wl);
              VT[(c16 + 2 * e) * LP + row] = (bf16)(vw[e] & 0xffffu); VT[(c16 + 2 * e + 1) * LP + row] = (bf16)(vw[e] >> 16); } }
        __syncthreads();
        { const int vb = 16 * w4; bf16x8 av[2];
#pragma unroll
          for (int k2 = 0; k2 < 2; ++k2) av[k2] = *(LAS bf16x8*)(VT + (vb + fr) * LP + 32 * k2 + 8 * fq);
          bf16* cl = sc.CL + (size_t)unit * 4096;
#pragma unroll
          for (int ct = 0; ct < 4; ++ct) { f32x4 acc = {0.f, 0.f, 0.f, 0.f};
#pragma unroll
              for (int k2 = 0; k2 < 2; ++k2) { const bf16x8 bw = *(LAS bf16x8*)(WKT + (16 * ct + fr) * LP + 32 * k2 + 8 * fq); acc = __builtin_amdgcn_mfma_f32_16x16x32_bf16(av[k2], bw, acc, 0, 0, 0); }
#pragma unroll
              for (int r = 0; r < 4; ++r) cl[(vb + 4 * fq + r) * 64 + 16 * ct + fr] = f2bf(acc[r]); }
          if (w4 == 1) { float ns = 0.f;
#pragma unroll
              for (int k8 = 0; k8 < 8; ++k8) { const u32x4 w = *(LAS u32x4*)(WKT + lane * LP + 8 * k8); ns += (bflo(w.x) + bfhi(w.x)) + (bflo(w.y) + bfhi(w.y)) + (bflo(w.z) + bfhi(w.z)) + (bflo(w.w) + bfhi(w.w)); }
              sc.NL[unit * 64 + lane] = ns; } }
        __syncthreads();
    }
}
__device__ __forceinline__ void phase_mlstm_scan(Frame& F) {
    const MlScr sc = ml_scr(F);
    for (int e = F.bid * NTHR + F.tid; e < 32 * 4096; e += F.nblk * NTHR) {
        const int bh = e >> 12, idx = e & 4095; float C = 0.f, m = 0.f, n = 0.f;
        bf16* p0 = sc.CL + (size_t)bh * 64 * 4096 + idx;
#pragma unroll 1
        for (int c0 = 0; c0 < 64; c0 += 16) {
            float cl[16];
#pragma unroll
            for (int j = 0; j < 16; ++j) cl[j] = bf2f(p0[(size_t)(c0 + j) * 4096]);
#pragma unroll
            for (int j = 0; j < 16; ++j) { const int unit = bh * 64 + c0 + j; const float ml = sc.MS[unit * 2], ft = sc.MS[unit * 2 + 1];
                const float m_new = fmaxf(ft + m, ml), a = __expf(ft + m - m_new), bb = __expf(ml - m_new);
                p0[(size_t)(c0 + j) * 4096] = f2bf(C); C = a * C + bb * cl[j];
                if (idx < 64) { float* q = sc.NL + unit * 64 + idx; const float nl = *q; *q = n; n = a * n + bb * nl; }
                if (idx == 0) sc.MIN[unit] = m;
                m = m_new; }
        }
    }
}
__device__ __forceinline__ void phase_mlstm_c(Frame& F, int l) {
    const MlScr sc = ml_scr(F);
    const int tid = F.tid, lane = F.lane, hw = tid >> 8, ht = tid & 255, w4 = F.wave & 3, fr = lane & 15, fq = lane >> 4;
    constexpr int LP = 72;
    LAS bf16* Qs = (LAS bf16*)(F.lds + hw * 65536); LAS bf16* Ks = Qs + 64 * LP; LAS bf16* VT = Ks + 64 * LP; LAS bf16* Ps = VT + 64 * LP; LAS bf16* Cb = Ps + 64 * LP; LAS bf16* NB = Cb + 64 * LP;
    LAS float* Fv = (LAS float*)(NB + 16 * LP); LAS float* Gv = Fv + 64; LAS float* MROW = Gv + 64; LAS float* WINT = MROW + 64;
    for (int u2 = F.bid; u2 < 1024; u2 += F.nblk) {
        const int unit = u2 * 2 + hw, c = unit & 63, h = (unit >> 6) & 3, b = unit >> 8, t0 = c * 64;
        const bf16* Zb = F.Z + (size_t)b * SEQ * NZ;
        const float bias_i = F.in[9][l * 8 + h], bias_f = F.in[9][l * 8 + 4 + h];
        const int row = ht >> 2, c16 = (ht & 3) * 16; const bf16* zr = Zb + (size_t)(t0 + row) * NZ + h * 64 + c16; const bf16* cin = sc.CL + (size_t)unit * 4096 + row * 64 + c16;
        const u32x4 q8a = *(const u32x4*)(zr + ZC_Q), q8b = *(const u32x4*)(zr + ZC_Q + 8), k8a = *(const u32x4*)(zr + ZC_K), k8b = *(const u32x4*)(zr + ZC_K + 8);
        const u32x4 v8a = *(const u32x4*)(zr + ZC_V), v8b = *(const u32x4*)(zr + ZC_V + 8), c8a = *(const u32x4*)(cin), c8b = *(const u32x4*)(cin + 8);
        if (w4 == 0) {
            const float m_prev = sc.MIN[unit];
            const bf16* zg = Zb + (size_t)(t0 + lane) * NZ; const float fp = bf2f(zg[ZC_F + h]) + bias_f, ig = bf2f(zg[ZC_I + h]) + bias_i;
            const float lf = -softplusf_(-fp); const float Fc = wave_scan_add(lf, lane); const float g = ig - Fc; const float pm = wave_scan_max(g, lane);
            const float mrow = Fc + fmaxf(m_prev, pm);
            Fv[lane] = Fc - mrow; Gv[lane] = g; MROW[lane] = mrow; WINT[lane] = __expf(Fc + m_prev - mrow);
            const bf16 nb = f2bf(sc.NL[unit * 64 + lane]);
#pragma unroll
            for (int r = 0; r < 16; ++r) NB[r * LP + lane] = nb;
        }
        *(LAS u32x4*)(Qs + row * LP + c16) = q8a; *(LAS u32x4*)(Qs + row * LP + c16 + 8) = q8b; *(LAS u32x4*)(Ks + row * LP + c16) = k8a; *(LAS u32x4*)(Ks + row * LP + c16 + 8) = k8b;
        *(LAS u32x4*)(Cb + row * LP + c16) = c8a; *(LAS u32x4*)(Cb + row * LP + c16 + 8) = c8b;
        { const unsigned vw[8] = {v8a.x, v8a.y, v8a.z, v8a.w, v8b.x, v8b.y, v8b.z, v8b.w};
#pragma unroll
          for (int e = 0; e < 8; ++e) { VT[(c16 + 2 * e) * LP + row] = (bf16)(vw[e] & 0xffffu); VT[(c16 + 2 * e + 1) * LP + row] = (bf16)(vw[e] >> 16); } }
        __syncthreads();
        {
            const int jb = 16 * w4; bf16x8 aq[2];
#pragma unroll
            for (int k2 = 0; k2 < 2; ++k2) aq[k2] = *(LAS bf16x8*)(Qs + (jb + fr) * LP + 32 * k2 + 8 * fq);
            f32x4 aS[4], aN[4], aQ = {0.f, 0.f, 0.f, 0.f};
#pragma unroll
            for (int ct = 0; ct < 4; ++ct) { aS[ct] = (f32x4){0.f, 0.f, 0.f, 0.f}; aN[ct] = (f32x4){0.f, 0.f, 0.f, 0.f};
#pragma unroll
                for (int k2 = 0; k2 < 2; ++k2) { const bf16x8 bk = *(LAS bf16x8*)(Ks + (16 * ct + fr) * LP + 32 * k2 + 8 * fq), bc = *(LAS bf16x8*)(Cb + (16 * ct + fr) * LP + 32 * k2 + 8 * fq);
                    aS[ct] = __builtin_amdgcn_mfma_f32_16x16x32_bf16(aq[k2], bk, aS[ct], 0, 0, 0); aN[ct] = __builtin_amdgcn_mfma_f32_16x16x32_bf16(aq[k2], bc, aN[ct], 0, 0, 0); } }
#pragma unroll
            for (int k2 = 0; k2 < 2; ++k2) { const bf16x8 bn = *(LAS bf16x8*)(NB + fr * LP + 32 * k2 + 8 * fq); aQ = __builtin_amdgcn_mfma_f32_16x16x32_bf16(aq[k2], bn, aQ, 0, 0, 0); }
            float fj[4], wi[4], mr[4], den[4];
#pragma unroll
            for (int r = 0; r < 4; ++r) { const int j = jb + 4 * fq + r; fj[r] = Fv[j]; wi[r] = WINT[j] * 0.125f; mr[r] = MROW[j]; den[r] = 0.f; }
#pragma unroll
            for (int ct = 0; ct < 4; ++ct) { const int s = 16 * ct + fr; const float gs = Gv[s];
#pragma unroll
                for (int r = 0; r < 4; ++r) { const int j = jb + 4 * fq + r; const float p = (s <= j) ? aS[ct][r] * 0.125f * __expf(fj[r] + gs) : 0.f; den[r] += p; Ps[j * LP + s] = f2bf(p); } }
            LDS_WAIT();
            f32x4 aP[4]; bf16x8 ap[2];
#pragma unroll
            for (int k2 = 0; k2 < 2; ++k2) ap[k2] = *(LAS bf16x8*)(Ps + (jb + fr) * LP + 32 * k2 + 8 * fq);
#pragma unroll
            for (int ct = 0; ct < 4; ++ct) { aP[ct] = (f32x4){0.f, 0.f, 0.f, 0.f};
#pragma unroll
                for (int k2 = 0; k2 < 2; ++k2) { const bf16x8 bv = *(LAS bf16x8*)(VT + (16 * ct + fr) * LP + 32 * k2 + 8 * fq); aP[ct] = __builtin_amdgcn_mfma_f32_16x16x32_bf16(ap[k2], bv, aP[ct], 0, 0, 0); } }
            float ssq[4];
#pragma unroll
            for (int r = 0; r < 4; ++r) { den[r] = row16_sum(den[r]) + wi[r] * aQ[r]; const float dd = fmaxf(fabsf(den[r]), __expf(-mr[r])); const float inv = rcpf_(dd); float s2 = 0.f;
#pragma unroll
                for (int ct = 0; ct < 4; ++ct) { const float hv = (aP[ct][r] + wi[r] * aN[ct][r]) * inv; aP[ct][r] = hv; s2 += hv * hv; }
                ssq[r] = rsqrtf(row16_sum(s2) * (1.f / 64.f) + EPS); }
#pragma unroll
            for (int ct = 0; ct < 4; ++ct) { const int v = 16 * ct + fr; const float hn = F.in[10][l * 256 + h * 64 + v];
#pragma unroll
                for (int r = 0; r < 4; ++r) { const size_t tok = (size_t)b * SEQ + t0 + jb + 4 * fq + r; const float og = bf2f(F.Z[tok * NZ + ZC_O + h * 64 + v]);
                    F.Y[tok * DM + h * 64 + v] = f2bf(aP[ct][r] * ssq[r] * hn * sigmoidf_(og)); } }
        }
        __syncthreads();
    }
}

__device__ __forceinline__ float gelu_tanh(float x) { const float u = 0.7978845608028654f * (x + 0.044715f * x * x * x); return 0.5f * x * (1.f + tanhf_(u)); }
template <bool OUT> __device__ __forceinline__ void phase_lru(Frame& F, int l) {
    float* LSUM = (float*)(F.ws + WS_SCR + SC_LSUM); float* LHIN = (float*)(F.ws + WS_SCR + SC_LHIN);
    const int blk = F.bid & 3, tid = F.tid, lane = F.lane, wave = F.wave, fr = lane & 15, fq = lane >> 4;
    constexpr int LP = 72;
    LAS bf16* WrT = (LAS bf16*)F.lds; LAS bf16* WiT = WrT + 64 * LP; LAS bf16* Xc = WiT + 64 * LP;
    LAS float* XcF = (LAS float*)(Xc + 64 * LP); LAS float* GR = XcF + 4096; LAS float* GI = GR + 4096;
    __syncthreads();
    for (int e = tid; e < 4096; e += NTHR) { const int d = e >> 6, ee = e & 63; const size_t wi = (((size_t)l * 4 + blk) * 64 + d) * 64 + ee;
        WrT[ee * LP + d] = f2bf(F.in[13][wi]); WiT[ee * LP + d] = f2bf(F.in[15][wi]); }
    const int ch = tid & 63, tg = tid >> 6, cg_ = blk * 64 + ch;
    float cw[4];
#pragma unroll
    for (int j = 0; j < 4; ++j) cw[j] = F.in[11][((size_t)l * 4 + j) * 256 + cg_];
    const float cb = F.in[12][l * 256 + cg_], sp = softplusf_(-F.in[17][l * 256 + cg_]);
    __syncthreads();
    for (int sq = F.bid >> 2; sq < 512; sq += F.nblk >> 2) {
        const int b = sq >> 6, c = sq & 63, unit = (b * 4 + blk) * 64 + c, t0 = c * 64;
        const bf16* Zb = F.Z + (size_t)b * SEQ * NZ;
        {   float xv[11];
#pragma unroll
            for (int k = 0; k < 11; ++k) { const int t = t0 + tg * 8 - 3 + k; xv[k] = (t >= 0) ? bf2f(Zb[(size_t)t * NZ + ZC_XB + cg_]) : 0.f; }
#pragma unroll
            for (int i = 0; i < 8; ++i) { const int tt = tg * 8 + i; const float xc = cb + (cw[0] * xv[i] + cw[1] * xv[i + 1]) + (cw[2] * xv[i + 2] + cw[3] * xv[i + 3]);
                Xc[tt * LP + ch] = f2bf(xc); XcF[tt * 64 + ch] = xc; } }
        __syncthreads();
        {   const int tb = 16 * (wave & 3), gate = wave >> 2; LAS bf16* WT = gate ? WiT : WrT; LAS float* G = gate ? GI : GR; const float* bias = (gate ? F.in[16] : F.in[14]) + l * 256 + blk * 64;
            bf16x8 ax[2];
#pragma unroll
            for (int k2 = 0; k2 < 2; ++k2) ax[k2] = *(LAS bf16x8*)(Xc + (tb + fr) * LP + 32 * k2 + 8 * fq);
#pragma unroll
            for (int ct = 0; ct < 4; ++ct) { f32x4 acc = {0.f, 0.f, 0.f, 0.f};
#pragma unroll
                for (int k2 = 0; k2 < 2; ++k2) { const bf16x8 bw = *(LAS bf16x8*)(WT + (16 * ct + fr) * LP + 32 * k2 + 8 * fq); acc = __builtin_amdgcn_mfma_f32_16x16x32_bf16(ax[k2], bw, acc, 0, 0, 0); }
                const float bs = bias[16 * ct + fr];
#pragma unroll
                for (int r = 0; r < 4; ++r) G[(tb + 4 * fq + r) * 64 + 16 * ct + fr] = sigmoidf_(acc[r] + bs); } }
        __syncthreads();
#pragma unroll
        for (int i = 0; i < 8; ++i) { const int e = (tg * 8 + i) * 64 + ch; const float r = GR[e], ig = GI[e], xc = XcF[e];
            const float la = -8.0f * r * sp, a = __expf(la), x2 = 2.f * la; const float om = (x2 > -0.03f) ? -x2 * (1.f + x2 * (0.5f + x2 * (0.16666667f + x2 * 0.041666668f))) : 1.f - a * a;
            const float u = sqrtf(om) * (ig * xc); GR[e] = a; GI[e] = u; }
        __syncthreads();
        if (wave == 0) {
            float hst = OUT ? LHIN[unit * 64 + lane] : 0.f, ap = 1.f;
#pragma unroll 8
            for (int tt = 0; tt < 64; ++tt) { const float a = GR[tt * 64 + lane]; hst = a * hst + GI[tt * 64 + lane]; if (OUT) XcF[tt * 64 + lane] = hst; else ap *= a; }
            if (!OUT) { LSUM[unit * 128 + lane] = ap; LSUM[unit * 128 + 64 + lane] = hst; } }
        if (OUT) {
            __syncthreads();
#pragma unroll
            for (int i = 0; i < 8; ++i) { const int tt = tg * 8 + i; const size_t tok = (size_t)b * SEQ + t0 + tt; const float gb = bf2f(F.Z[tok * NZ + ZC_GB + cg_]);
                F.Y[tok * DM + 256 + cg_] = f2bf(XcF[tt * 64 + ch] * gelu_tanh(gb)); } }
        __syncthreads();
    }
}
__device__ __forceinline__ void phase_lru_carry(Frame& F) {
    float* LSUM = (float*)(F.ws + WS_SCR + SC_LSUM); float* LHIN = (float*)(F.ws + WS_SCR + SC_LHIN);
    const int e = F.bid * NTHR + F.tid;
    if (e < 2048) { const int b = e >> 8, chn = e & 255, blk = chn >> 6, ch = chn & 63; float h = 0.f;
#pragma unroll 8
        for (int c = 0; c < 64; ++c) { const int unit = (b * 4 + blk) * 64 + c; LHIN[unit * 64 + ch] = h; h = LSUM[unit * 128 + ch] * h + LSUM[unit * 128 + 64 + ch]; } }
}
__device__ __forceinline__ void phase_mix1(Frame& F, int l) { phase_mlstm_a(F, l); phase_lru<false>(F, l); }
__device__ __forceinline__ void phase_mix2(Frame& F, int l) { phase_mlstm_scan(F); phase_lru_carry(F); __syncthreads(); for (int u = F.bid; u < 256; u += F.nblk) rw_rec_unit2(F, l, u); }
__device__ __forceinline__ void phase_mix3(Frame& F, int l) { phase_mlstm_c(F, l); phase_lru<true>(F, l); phase_rw_epi2(F, l); }
constexpr int PH_PER_LAYER = 12, N_PHASES = 1 + DEPTH * PH_PER_LAYER;
#ifndef PHM
#define PHM 1023
#endif
#ifndef MK_ONE_LAUNCH
#define MK_ONE_LAUNCH 1
#endif

#ifndef PROBE_REP
#define PROBE_REP 0
#define PROBE_LO 1
#define PROBE_HI 3
#endif
constexpr int PROBE_LEN = PROBE_HI - PROBE_LO + 1, LAYER_STEPS = PH_PER_LAYER + PROBE_REP * PROBE_LEN, N_STEPS = 1 + DEPTH * LAYER_STEPS;
__device__ __forceinline__ int sched_phase(int st) {
    if (st == 0) return 0;
    const int l = (st - 1) / LAYER_STEPS; int k = (st - 1) % LAYER_STEPS;
    if (k > PROBE_HI) { const int e = k - PROBE_HI - 1; k = (e < PROBE_REP * PROBE_LEN) ? PROBE_LO + e % PROBE_LEN : k - PROBE_REP * PROBE_LEN; }
    return 1 + l * PH_PER_LAYER + k;
}
__global__ void __launch_bounds__(NTHR, 2) mega(Args a) {
    extern __shared__ __attribute__((aligned(16))) unsigned char lds_raw[];
    Frame F;
    F.lds = (LAS unsigned char*)lds_raw; F.ws = a.ws; F.out = a.out;
    F.XN = (bf16*)(a.ws + WS_XN); F.Y = (bf16*)(a.ws + WS_Y); F.Z = (bf16*)(a.ws + WS_Z); F.HID = (bf16*)(a.ws + WS_SCR); F.PB = (bf16*)(a.ws + WS_PB);
    F.SSQ = (float*)(a.ws + WS_SSQ); F.BON = (float*)(a.ws + WS_BON);
    for (int st = a.ph_lo; st < a.ph_hi; ++st) {
        if (st > a.ph_lo) cg::this_grid().sync();
        const int ph = sched_phase(st);
        { auto ka = __builtin_amdgcn_kernarg_segment_ptr(); asm volatile("" : "+s"(ka)); F.in = (KTab)ka; }
        { int tv = threadIdx.x, bv = blockIdx.x, gv = gridDim.x; asm volatile("" : "+v"(tv), "+s"(bv), "+s"(gv));
          F.tid = tv; F.lane = tv & 63; F.wave = __builtin_amdgcn_readfirstlane(tv >> 6); F.bid = bv; F.nblk = gv; }
        if (ph == 0) { phase_prologue(F); continue; }
        const int l = (ph - 1) / PH_PER_LAYER, k = (ph - 1) % PH_PER_LAYER;
        bf16* wl = wlayer(F, l);
        if (k == 0 || k == 9) {
            const bf16* A = (k == 0) ? F.XN : F.PB + (size_t)l * MTOK * DPLE; const bf16* Bt = (k == 0) ? wl + WO_IN : wl + WO_P;
            const int N = (k == 0) ? NZ : DM, K = (k == 0) ? DM : DPLE; bf16* O = (k == 0) ? F.Z : F.Y;
            phase_gemm<0>(F, A, Bt, N, K, O, N);
        } else if (k == 1) { phase_mix1(F, l);
        } else if (k == 2) { phase_mix2(F, l);
        } else if (k == 3) { phase_mix3(F, l);
        } else if (k == 4 || k == 7) {
            const bf16* A = (k == 4) ? F.Y : F.HID; const bf16* Bt = (k == 4) ? wl + WO_OUT : wl + WO_2; const int K = (k == 4) ? DM : DFF;
            phase_gemm<2>(F, A, Bt, DM, K, F.XN, DM);
        } else if (k == 5) { phase_rowpass<true>(F, l == 0 ? F.in[0] : a.out, F.XN, F.in[3] + l * DM, a.out, F.XN, F.in[4] + l * DM);
        } else if (k == 6) { phase_gemm<1>(F, F.XN, wl + WO_1, DFF, DM, F.HID, DFF);
        } else if (k == 8) { phase_rowpass<false>(F, a.out, F.XN, F.in[5] + l * DM, a.out, F.XN, nullptr);
        } else if (k == 10) { phase_gemm<3>(F, F.XN, wl + WO_G, DM, DM, F.Y, DM);
        } else { phase_rowpass<true>(F, a.out, F.Y, F.in[6] + l * DM, a.out, (l + 1 < DEPTH) ? F.XN : nullptr, F.in[2] + (l + 1 < DEPTH ? (l + 1) * DM : 0)); }
    }
}

extern "C" void kernel_launch(void* const* d_in, const int* in_sizes, int n_in, void* d_out, int out_size, void* d_ws, size_t ws_size, hipStream_t stream) {
    static int grid = 0;
    if (grid == 0) {
        if (n_in != 33 || out_size != MTOK * DM || ws_size < WS_END) { fprintf(stderr, "kernel_launch: unexpected shapes (n_in %d out %d ws %zu)\n", n_in, out_size, ws_size); grid = -1; return; }
        if (hipFuncSetAttribute((const void*)mega, hipFuncAttributeMaxDynamicSharedMemorySize, LDS_BYTES) != hipSuccess) { fprintf(stderr, "kernel_launch: hipFuncSetAttribute failed\n"); grid = -1; return; }
        int dev = 0, cus = 0, per_cu = 0;
        (void)hipGetDevice(&dev); (void)hipDeviceGetAttribute(&cus, hipDeviceAttributeMultiprocessorCount, dev);
        (void)hipOccupancyMaxActiveBlocksPerMultiprocessor(&per_cu, (const void*)mega, NTHR, LDS_BYTES);
        if (per_cu < 1) { fprintf(stderr, "kernel_launch: occupancy query says %d blocks per CU\n", per_cu); per_cu = 1; }
        (void)hipGetLastError();
        grid = cus;
        if (grid != 256) fprintf(stderr, "kernel_launch: note: %d CUs\n", grid);
    }
    if (grid < 0) return;
    Args a{};
    for (int i = 0; i < 33; ++i) a.in[i] = (const float*)d_in[i];
    a.out = (float*)d_out; a.ws = (unsigned char*)d_ws;
#if MK_ONE_LAUNCH
    a.ph_lo = 0; a.ph_hi = N_STEPS;
    void* params[] = {&a};
    hipError_t e = hipLaunchCooperativeKernel((const void*)mega, dim3(grid), dim3(NTHR), params, LDS_BYTES, stream);
    if (e != hipSuccess) fprintf(stderr, "kernel_launch: cooperative launch failed: %s\n", hipGetErrorString(e));
#else
    for (int ph = 0; ph < N_STEPS; ++ph) { a.ph_lo = ph; a.ph_hi = ph + 1; hipLaunchKernelGGL(mega, dim3(grid), dim3(NTHR), LDS_BYTES, stream, a); }
#endif
}
```
